# Optimizing an MI355X kernel written in HIP

```python
import jax, jax.numpy as jnp
from jax import lax
import numpy as np

D_MODEL = 1024
BATCH = 16
SEQ = 2048
DEPTH = 4

N_HEADS = 8
QK_NOPE_DIM = 128
QK_ROPE_DIM = 64
QK_DIM = QK_NOPE_DIM + QK_ROPE_DIM
V_HEAD_DIM = 128
Q_LORA_RANK = 384
KV_LORA_RANK = 256
ROPE_THETA = 10000.0
Q_BLOCK = 128
POOL_WINDOWS = (2, 4, 8, 16)
N_POOL_GROUPS = 4
POOL_GROUP_DIM = 128
POOL_DIM = N_POOL_GROUPS * POOL_GROUP_DIM
N_BRANCHES = 2
IN_DIM = POOL_DIM + Q_LORA_RANK + KV_LORA_RANK + QK_ROPE_DIM + N_BRANCHES * D_MODEL
SPLIT_POINTS = (POOL_DIM,
                POOL_DIM + Q_LORA_RANK,
                POOL_DIM + Q_LORA_RANK + KV_LORA_RANK,
                POOL_DIM + Q_LORA_RANK + KV_LORA_RANK + QK_ROPE_DIM)
D_FF = 2816
NORM_EPS = 1e-6

kernel_name = "macaron_gated_pool_mla_trunk"


def rms_norm(x, g):
    xf = x.astype(jnp.float32)
    y = xf * lax.rsqrt(jnp.mean(xf * xf, axis=-1, keepdims=True) + NORM_EPS)
    return (y * g.astype(jnp.float32)).astype(x.dtype)


def swiglu_ffn(h, w_up, w_down):
    gate, up = jnp.split(h @ w_up, 2, axis=-1)
    return (jax.nn.silu(gate) * up) @ w_down


def rope_tables(positions):
    inv_freq = ROPE_THETA ** (-jnp.arange(0, QK_ROPE_DIM, 2, dtype=jnp.float32) / QK_ROPE_DIM)
    ang = positions.astype(jnp.float32)[..., None] * inv_freq
    return jnp.cos(ang), jnp.sin(ang)


def apply_rope(x, cos, sin):
    xf = x.astype(jnp.float32)
    x1, x2 = jnp.split(xf, 2, axis=-1)
    out = jnp.concatenate([x1 * cos - x2 * sin, x2 * cos + x1 * sin], axis=-1)
    return out.astype(x.dtype)


def causal_multiscale_pool(xp, pool_maps, pool_scale):
    B, S, _ = xp.shape
    xg = xp.reshape(B, S, N_POOL_GROUPS, POOL_GROUP_DIM).astype(jnp.float32)
    csum = jnp.pad(jnp.cumsum(xg, axis=1), ((0, 0), (1, 0), (0, 0), (0, 0)))
    windows = jnp.array(POOL_WINDOWS, dtype=jnp.int32)
    t = jnp.arange(S, dtype=jnp.int32)[:, None]
    start = jnp.maximum(t + 1 - windows[None, :], 0)
    csum_start = csum[:, start, jnp.arange(N_POOL_GROUPS)[None, :]]
    count = jnp.minimum(t + 1, windows[None, :]).astype(jnp.float32)
    pooled = (csum[:, 1:] - csum_start) / count[None, :, :, None] - xg
    mixed = jnp.einsum('bsgc,gcd->bsgd', pooled.astype(xp.dtype), pool_maps)
    return mixed.reshape(B, S, POOL_DIM) * pool_scale


def mla_attention(q_lat, kv_lat, k_rope, cos, sin, q_norm, w_uq, kv_norm, w_ukv):
    B, S, _ = q_lat.shape
    q = (rms_norm(q_lat, q_norm) @ w_uq).reshape(B, S, N_HEADS, QK_DIM)
    q_nope, q_rope = q[..., :QK_NOPE_DIM], q[..., QK_NOPE_DIM:]
    kv = (rms_norm(kv_lat, kv_norm) @ w_ukv).reshape(B, S, N_HEADS, QK_NOPE_DIM + V_HEAD_DIM)
    k_nope, v = kv[..., :QK_NOPE_DIM], kv[..., QK_NOPE_DIM:]
    q_rope = apply_rope(q_rope, cos[:, :, None, :], sin[:, :, None, :])
    k_rope = apply_rope(k_rope, cos, sin)
    scale = QK_DIM ** -0.5
    outs = []
    for blk in range(S // Q_BLOCK):
        q0 = blk * Q_BLOCK
        k_end = q0 + Q_BLOCK
        s = (jnp.einsum('bqhd,bkhd->bhqk', q_nope[:, q0:k_end], k_nope[:, :k_end])
             + jnp.einsum('bqhr,bkr->bhqk', q_rope[:, q0:k_end], k_rope[:, :k_end]))
        s = s.astype(jnp.float32) * scale
        mask = (q0 + jnp.arange(Q_BLOCK))[:, None] >= jnp.arange(k_end)[None, :]
        s = jnp.where(mask[None, None], s, jnp.finfo(jnp.float32).min)
        p = jax.nn.softmax(s, axis=-1).astype(v.dtype)
        outs.append(jnp.einsum('bhqk,bkhd->bqhd', p, v[:, :k_end]))
    o = jnp.concatenate(outs, axis=1)
    return o.reshape(B, S, N_HEADS * V_HEAD_DIM)


def setup_inputs(seed: int = 0) -> dict:
    key = jax.random.key(seed)
    ks = jax.random.split(key, 24)
    f32 = jnp.float32

    def w(k, shape, fan_in):
        return jax.random.normal(k, shape, f32) * (fan_in ** -0.5)

    def gain(k, shape):
        return 1.0 + 0.02 * jax.random.normal(k, shape, f32)

    L, D = DEPTH, D_MODEL
    offsets = jax.random.randint(ks[1], (BATCH, 1), 0, 4096, dtype=jnp.int32)
    positions = offsets + jnp.arange(SEQ, dtype=jnp.int32)[None, :]
    return {
        "x": jax.random.normal(ks[0], (BATCH, SEQ, D), f32),
        "positions": positions,
        "norm_ffn1": gain(ks[2], (L, D)),
        "ffn1_up": w(ks[3], (L, D, 2 * D_FF), D),
        "ffn1_down": w(ks[4], (L, D_FF, D), D_FF),
        "norm_mix": gain(ks[5], (L, D)),
        "w_in": w(ks[6], (L, D, IN_DIM), D),
        "b_gate": 0.02 * jax.random.normal(ks[7], (L, N_BRANCHES * D), f32),
        "pool_maps": w(ks[8], (L, N_POOL_GROUPS, POOL_GROUP_DIM, POOL_GROUP_DIM), POOL_GROUP_DIM),
        "pool_scale": 1.0 + 0.1 * jax.random.normal(ks[9], (L, POOL_DIM), f32),
        "w_pool_proj": w(ks[10], (L, POOL_DIM, D), POOL_DIM),
        "q_latent_norm": gain(ks[11], (L, Q_LORA_RANK)),
        "w_uq": w(ks[12], (L, Q_LORA_RANK, N_HEADS * QK_DIM), Q_LORA_RANK),
        "kv_latent_norm": gain(ks[13], (L, KV_LORA_RANK)),
        "w_ukv": w(ks[14], (L, KV_LORA_RANK, N_HEADS * (QK_NOPE_DIM + V_HEAD_DIM)), KV_LORA_RANK),
        "w_attn_proj": w(ks[15], (L, N_HEADS * V_HEAD_DIM, D), N_HEADS * V_HEAD_DIM),
        "w_out": w(ks[16], (L, D, D), D),
        "norm_ffn2": gain(ks[17], (L, D)),
        "ffn2_up": w(ks[18], (L, D, 2 * D_FF), D),
        "ffn2_down": w(ks[19], (L, D_FF, D), D_FF),
        "final_norm": gain(ks[20], (D,)),
    }


def reference(x, positions, norm_ffn1, ffn1_up, ffn1_down, norm_mix, w_in, b_gate,
              pool_maps, pool_scale, w_pool_proj, q_latent_norm, w_uq, kv_latent_norm,
              w_ukv, w_attn_proj, w_out, norm_ffn2, ffn2_up, ffn2_down, final_norm):
    B, S, D = x.shape
    cos, sin = rope_tables(positions)
    for l in range(DEPTH):
        x = x + 0.5 * swiglu_ffn(rms_norm(x, norm_ffn1[l]), ffn1_up[l], ffn1_down[l])
        h = rms_norm(x, norm_mix[l])
        proj = h @ w_in[l]
        x_pool, q_lat, kv_lat, k_rope, gate_logits = jnp.split(proj, SPLIT_POINTS, axis=-1)
        gates = jax.nn.sigmoid((gate_logits + b_gate[l]).astype(jnp.float32)).astype(x.dtype)
        gates = gates.reshape(B, S, N_BRANCHES, D)
        branch_a = causal_multiscale_pool(x_pool, pool_maps[l], pool_scale[l]) @ w_pool_proj[l]
        branch_b = mla_attention(q_lat, kv_lat, k_rope, cos, sin, q_latent_norm[l], w_uq[l],
                                 kv_latent_norm[l], w_ukv[l]) @ w_attn_proj[l]
        merged = gates[:, :, 0] * branch_a + gates[:, :, 1] * branch_b
        x = x + merged @ w_out[l]
        x = x + 0.5 * swiglu_ffn(rms_norm(x, norm_ffn2[l]), ffn2_up[l], ffn2_down[l])
    return rms_norm(x, final_norm)
```

```cpp
#include <hip/hip_runtime.h>
#include <hip/hip_cooperative_groups.h>
#include <cstdio>
#include <cstdint>
namespace cg = cooperative_groups;

#define LAS __attribute__((address_space(3)))
typedef unsigned short bf16_t;
typedef short bf16x8 __attribute__((ext_vector_type(8)));
typedef float f32x4 __attribute__((ext_vector_type(4)));
typedef float f32x16 __attribute__((ext_vector_type(16)));
typedef unsigned u32x4 __attribute__((ext_vector_type(4)));
typedef unsigned u32x2 __attribute__((ext_vector_type(2)));
typedef float f32x2_t __attribute__((ext_vector_type(2)));
typedef __bf16 bf16x2_t __attribute__((ext_vector_type(2)));


__device__ __forceinline__ int fresh_lane() { int l; asm volatile("v_mbcnt_lo_u32_b32 %0, -1, 0\n\tv_mbcnt_hi_u32_b32 %0, -1, %0" : "=v"(l)); return l; }
__device__ __forceinline__ int fresh_tid(int wave_s) { return (wave_s << 6) | fresh_lane(); }

constexpr int BATCH = 16, SEQ = 2048, DM = 1024, DEPTH = 4, NH = 8, DFF = 2816;
constexpr int M = BATCH * SEQ;
constexpr int QLR = 384, KVLR = 256, INDIM = 3264;
constexpr float EPS = 1e-6f;
constexpr float QSCALE = 0.07216878364870322f * 1.4426950408889634f;

constexpr size_t W_UP1 = 0;
constexpr size_t W_DN1 = W_UP1 + (size_t)5632 * 1024;
constexpr size_t W_IN5 = W_DN1 + (size_t)1024 * 2816;
constexpr size_t W_G   = W_IN5 + (size_t)1280 * 1024;
constexpr size_t W_PM  = W_G + (size_t)2048 * 1024;
constexpr size_t W_PP  = W_PM + (size_t)512 * 512;
constexpr size_t W_UQ  = W_PP + (size_t)1024 * 512;
constexpr size_t W_UKV = W_UQ + (size_t)1536 * 384;
constexpr size_t W_AP  = W_UKV + (size_t)2048 * 256;
constexpr size_t W_WO  = W_AP + (size_t)1024 * 1024;
constexpr size_t W_UP2 = W_WO + (size_t)1024 * 1024;
constexpr size_t W_DN2 = W_UP2 + (size_t)5632 * 1024;
constexpr size_t W_END = W_DN2 + (size_t)1024 * 2816;

constexpr size_t MiB = 1u << 20;
constexpr size_t WS_W = 1 * MiB;
static_assert(W_END * 2 <= 48 * MiB, "weight region");
constexpr size_t WS_XB = 49 * MiB;
constexpr size_t WS_SSQX = 113 * MiB;
constexpr size_t WS_SSQQ = 115 * MiB;
constexpr size_t WS_SSQKV = 116 * MiB;
constexpr size_t WS_CS = 117 * MiB;
constexpr size_t WS_BIG = 125 * MiB;
constexpr size_t WS_END = WS_BIG + 356 * MiB;
constexpr size_t B_H = 0;
constexpr size_t B_QB = 0, B_KN = 96, B_VT = 160, B_KR = 224, B_POOLED = 228, B_AO = 260, B_MIXED = 324;
constexpr size_t B_XPOOL = 260, B_KVLAT = 292, B_QLAT = 308;
constexpr size_t B_G = 0, B_MB = 64;

__device__ __forceinline__ unsigned pk2(float lo, float hi) { f32x2_t v = {lo, hi}; bf16x2_t b = __builtin_convertvector(v, bf16x2_t); return __builtin_bit_cast(unsigned, b); }
__device__ __forceinline__ u32x4 pack8(f32x4 a, f32x4 b) { u32x4 w; w.x = pk2(a[0], a[1]); w.y = pk2(a[2], a[3]); w.z = pk2(b[0], b[1]); w.w = pk2(b[2], b[3]); return w; }
__device__ __forceinline__ float bf2f(unsigned bits16) { return __uint_as_float(bits16 << 16); }
__device__ __forceinline__ float dot4(f32x4 a) { return (a[0] * a[0] + a[1] * a[1]) + (a[2] * a[2] + a[3] * a[3]); }
template <int NP> __device__ __forceinline__ float rstd_from(const float* p, float inv_n) {
    float s = 0.f;
#pragma unroll
    for (int i = 0; i < NP / 4; ++i) { const f32x4 v = *(const f32x4*)(p + 4 * i); s += (v[0] + v[1]) + (v[2] + v[3]); }
    return __builtin_amdgcn_rsqf(s * inv_n + EPS);
}


template <int NP> __device__ __forceinline__ void rstd8(float (&rs)[8], const float* ssq, int row0, int fq, float inv_n) {
    constexpr int PER = NP / 4;
    float s[8];
#pragma unroll
    for (int i = 0; i < 8; ++i) { const float* p = ssq + (size_t)(row0 + (i >> 2) * 128 + (i & 3) * 16) * NP + PER * fq;
        if (PER == 4) { const f32x4 v = *(const f32x4*)p; s[i] = (v[0] + v[1]) + (v[2] + v[3]); }
        else if (PER == 2) { const f32x2_t v = *(const f32x2_t*)p; s[i] = v[0] + v[1]; }
        else s[i] = *p; }
#pragma unroll
    for (int i = 0; i < 8; ++i) { float t = s[i]; t += __shfl_xor(t, 16); t += __shfl_xor(t, 32); rs[i] = __builtin_amdgcn_rsqf(t * inv_n + EPS); }
}

namespace pg8 {
constexpr int BM = 256, BK = 64, HALF = 128, HTB = HALF * BK * 2, STAGE_BYTES = 8 * HTB, NXCD = 8, WGM = 8;
__host__ __device__ __forceinline__ int lds_byte(int r, int c) { const int st = (r >> 4) * 2 + (c >> 5), rr = r & 15, cc = c & 31, ob = rr * 64 + cc * 2; return st * 1024 + (ob ^ (((ob >> 9) & 1) << 5)); }
__host__ __device__ __forceinline__ void stage_rc(int b, int& R, int& C) { const int st = b / 1024, sb = b % 1024, swz = sb ^ (((sb >> 9) & 1) << 5); R = (st >> 1) * 16 + swz / 64; C = (st & 1) * 32 + (swz % 64) / 2; }
__host__ __device__ __forceinline__ int perm32(int rho) { const int n = rho >> 4, i = rho & 15; return 8 * (i >> 2) + 4 * n + (i & 3); }

struct Unit { int pm, pn; };
struct Gemm { const bf16_t* A; const bf16_t* Bt; int M, N, K; };

struct StaticOrder {
    int nM, nN, nwg, G, c;
    __device__ void init(int M_, int N_, int G_, int c_) { nM = M_ / BM; nN = N_ / BM; nwg = nM * nN; G = G_; c = c_; }
    __device__ bool next(int i, Unit& u) const {
        const long L = (long)i * G + c; if (L >= nwg) return false;
        int wgid = (int)L; { const int q = nwg / NXCD, r = nwg % NXCD, xcd = wgid % NXCD, off = wgid / NXCD; wgid = (xcd < r ? xcd * (q + 1) : r * (q + 1) + (xcd - r) * q) + off; }
        const int nig = WGM * nN, gid = wgid / nig, fm = gid * WGM, gsz = (nM - fm) < WGM ? (nM - fm) : WGM;
        u.pm = fm + ((wgid % nig) % gsz); u.pn = (wgid % nig) / gsz; return true;
    }
};

template <class Epi, bool ALIGN_EPI = true, bool SP2 = true>
__device__ __forceinline__ void gemm_phase(LAS unsigned char* lds, const Gemm g, const StaticOrder& S, const Epi& E, int wave_s) {
    const int tid = fresh_tid(wave_s);
    const int wid = __builtin_amdgcn_readfirstlane(tid >> 6), lane = tid & 63, wr = wid >> 2, wc = wid & 3, fr = lane & 15, fq = lane >> 4;
    const int K = g.K, nt = K / BK;
    unsigned voffA[2], voffB[2];
#pragma unroll
    for (int i = 0; i < 2; ++i) { int R, C; stage_rc(tid * 16 + i * 8192, R, C); const int Rb = Epi::PERM ? ((R & ~31) + perm32(R & 31)) : R;
        voffA[i] = (unsigned)(R * K + C) * 2u; voffB[i] = (unsigned)(Rb * K + C) * 2u; }
    const size_t kstep = (size_t)(BK * 2);
    const size_t hstep = (size_t)HALF * K * 2;
    const size_t tstep = 2 * hstep;
    const unsigned ldsw = (unsigned)wid * 1024u;
    const int aoff = lds_byte(wr * 64 + fr, fq * 8), boff = lds_byte(wc * 32 + fr, fq * 8);
#define PG8_SA(b, h) (((b) * 2 + (h)) * HTB)
#define PG8_SB(b, h) ((4 + (b) * 2 + (h)) * HTB)
#define PG8_STAGE(bufoff, gbase, voff) do { _Pragma("unroll") for (int _i = 0; _i < 2; ++_i) \
        __builtin_amdgcn_global_load_lds((const unsigned*)((const char*)(gbase) + (voff)[_i]), (LAS unsigned*)(lds + (bufoff) + ldsw + _i * 8192), 16, 0, 0); } while (0)
#define PG8_LDA(dst, b, h) do { _Pragma("unroll") for (int m = 0; m < 4; ++m) _Pragma("unroll") for (int k = 0; k < 2; ++k) dst[m][k] = *(const LAS bf16x8*)(lds + PG8_SA(b, h) + aoff + m * 2048 + k * 1024); } while (0)
#define PG8_LDB(dst, b, h) do { _Pragma("unroll") for (int n = 0; n < 2; ++n) _Pragma("unroll") for (int k = 0; k < 2; ++k) dst[n][k] = *(const LAS bf16x8*)(lds + PG8_SB(b, h) + boff + n * 2048 + k * 1024); } while (0)
#define PG8_MMA(ai, bj, At, Bt) do { __builtin_amdgcn_s_setprio(1); _Pragma("unroll") for (int m = 0; m < 4; ++m) _Pragma("unroll") for (int n = 0; n < 2; ++n) _Pragma("unroll") for (int k = 0; k < 2; ++k) \
        acc[ai][bj][m][n] = __builtin_amdgcn_mfma_f32_16x16x32_bf16(Bt[n][k], At[m][k], acc[ai][bj][m][n], 0, 0, 0); __builtin_amdgcn_s_setprio(0); } while (0)
#define PG8_WAIT_V(n) asm volatile("s_waitcnt vmcnt(" #n ")" ::: "memory")
#define PG8_WAIT_L(n) asm volatile("s_waitcnt lgkmcnt(" #n ")" ::: "memory")
#define PG8_BAR __builtin_amdgcn_s_barrier()
#define PG8_SCHED __builtin_amdgcn_sched_barrier(0)
    Unit cur, nxt; int ui = 0;
    if (!S.next(0, cur)) return;
    f32x4 acc[2][2][4][2];
#pragma unroll
    for (int a = 0; a < 2; ++a)
#pragma unroll
        for (int b = 0; b < 2; ++b)
#pragma unroll
            for (int m = 0; m < 4; ++m)
#pragma unroll
                for (int n = 0; n < 2; ++n) acc[a][b][m][n] = (f32x4){0.f, 0.f, 0.f, 0.f};
    bf16x8 At[4][2], B0[2][2], B1[2][2];
    const char* cA = (const char*)g.A + (size_t)cur.pm * tstep; const char* cB = (const char*)g.Bt + (size_t)cur.pn * tstep;
    if constexpr (SP2) {
        PG8_STAGE(PG8_SB(0, 0), cB, voffB); PG8_STAGE(PG8_SB(0, 1), cB + hstep, voffB); PG8_STAGE(PG8_SA(0, 0), cA, voffA); PG8_STAGE(PG8_SA(0, 1), cA + hstep, voffA);
        if (wr == 1) PG8_BAR;
        PG8_WAIT_V(2); PG8_BAR;
        PG8_STAGE(PG8_SB(1, 0), cB + kstep, voffB); PG8_STAGE(PG8_SA(1, 0), cA + kstep, voffA); PG8_STAGE(PG8_SB(1, 1), cB + hstep + kstep, voffB);
        PG8_WAIT_V(6); PG8_BAR;
    } else {
        PG8_STAGE(PG8_SB(0, 0), cB, voffB); PG8_STAGE(PG8_SA(0, 0), cA, voffA); PG8_STAGE(PG8_SB(0, 1), cB + hstep, voffB); PG8_STAGE(PG8_SA(0, 1), cA + hstep, voffA);
        if (wr == 1) PG8_BAR;
        PG8_WAIT_V(4); PG8_BAR;
        PG8_STAGE(PG8_SB(1, 0), cB + kstep, voffB); PG8_STAGE(PG8_SA(1, 0), cA + kstep, voffA); PG8_STAGE(PG8_SB(1, 1), cB + hstep + kstep, voffB);
        PG8_WAIT_V(6); PG8_BAR;
    }
    for (;;) {
        const bool has_next = S.next(ui + 1, nxt);
        const char* nA = has_next ? (const char*)g.A + (size_t)nxt.pm * tstep : cA; const char* nB = has_next ? (const char*)g.Bt + (size_t)nxt.pn * tstep : cB;
        for (int t = 0; t < nt; t += 2) {
            const bool last = (t == nt - 2);
            const char* a1 = cA + (size_t)(t + 1) * kstep;
            const char* a2 = last ? nA : cA + (size_t)(t + 2) * kstep; const char* b2 = last ? nB : cB + (size_t)(t + 2) * kstep;
            const char* a3 = a2 + kstep; const char* b3 = b2 + kstep;
            asm volatile("" : "+s"(a1), "+s"(a2), "+s"(b2), "+s"(a3), "+s"(b3));
            if constexpr (SP2) {
            PG8_LDB(B0, 0, 0); PG8_LDB(B1, 0, 1); PG8_SCHED; PG8_LDA(At, 0, 0); PG8_STAGE(PG8_SA(1, 1), a1 + hstep, voffA);
            PG8_WAIT_V(8); PG8_WAIT_L(0); PG8_BAR; PG8_MMA(0, 0, At, B0); PG8_MMA(0, 1, At, B1); PG8_BAR; PG8_SCHED;
            PG8_LDA(At, 0, 1); PG8_STAGE(PG8_SB(0, 0), b2, voffB); PG8_STAGE(PG8_SB(0, 1), b2 + hstep, voffB); PG8_STAGE(PG8_SA(0, 0), a2, voffA);
            PG8_WAIT_V(8); PG8_WAIT_L(0); PG8_BAR; PG8_MMA(1, 0, At, B0); PG8_MMA(1, 1, At, B1); PG8_BAR; PG8_SCHED;
            PG8_LDB(B0, 1, 0); PG8_LDB(B1, 1, 1); PG8_SCHED; PG8_LDA(At, 1, 0); PG8_STAGE(PG8_SA(0, 1), a2 + hstep, voffA);
            PG8_WAIT_V(8); PG8_WAIT_L(0); PG8_BAR; PG8_MMA(0, 0, At, B0); PG8_MMA(0, 1, At, B1); PG8_BAR; PG8_SCHED;
            PG8_LDA(At, 1, 1); PG8_STAGE(PG8_SB(1, 0), b3, voffB); PG8_STAGE(PG8_SB(1, 1), b3 + hstep, voffB); PG8_STAGE(PG8_SA(1, 0), a3, voffA);
            PG8_WAIT_V(8); PG8_WAIT_L(0); PG8_BAR; PG8_MMA(1, 0, At, B0); PG8_MMA(1, 1, At, B1); PG8_BAR; PG8_SCHED;
            } else {
            PG8_LDB(B0, 0, 0); PG8_SCHED; PG8_LDA(At, 0, 0); PG8_STAGE(PG8_SA(1, 1), a1 + hstep, voffA);
            PG8_WAIT_L(8); PG8_BAR; PG8_WAIT_L(0); PG8_MMA(0, 0, At, B0); PG8_BAR; PG8_SCHED;
            PG8_LDB(B1, 0, 1); PG8_STAGE(PG8_SB(0, 0), b2, voffB);
            PG8_BAR; PG8_WAIT_L(0); PG8_MMA(0, 1, At, B1); PG8_BAR;
            PG8_LDA(At, 0, 1); PG8_STAGE(PG8_SA(0, 0), a2, voffA);
            PG8_BAR; PG8_WAIT_L(0); PG8_MMA(1, 0, At, B0); PG8_BAR; PG8_SCHED;
            PG8_STAGE(PG8_SB(0, 1), b2 + hstep, voffB);
            PG8_WAIT_V(6); PG8_BAR; PG8_MMA(1, 1, At, B1); PG8_BAR;
            PG8_LDB(B0, 1, 0); PG8_SCHED; PG8_LDA(At, 1, 0); PG8_STAGE(PG8_SA(0, 1), a2 + hstep, voffA);
            PG8_WAIT_L(8); PG8_BAR; PG8_WAIT_L(0); PG8_MMA(0, 0, At, B0); PG8_BAR; PG8_SCHED;
            PG8_LDB(B1, 1, 1); PG8_STAGE(PG8_SB(1, 0), b3, voffB);
            PG8_BAR; PG8_WAIT_L(0); PG8_MMA(0, 1, At, B1); PG8_BAR;
            PG8_LDA(At, 1, 1); PG8_STAGE(PG8_SA(1, 0), a3, voffA);
            PG8_BAR; PG8_WAIT_L(0); PG8_MMA(1, 0, At, B0); PG8_BAR; PG8_SCHED;
            PG8_STAGE(PG8_SB(1, 1), b3 + hstep, voffB);
            PG8_WAIT_V(6); PG8_BAR; PG8_MMA(1, 1, At, B1); PG8_BAR;
            }
        }
        if constexpr (ALIGN_EPI) { if (wr == 0) PG8_BAR; }
        E(acc, cur, wr, wc, fr, fq);
        if (!has_next) break;
#pragma unroll
        for (int a = 0; a < 2; ++a)
#pragma unroll
            for (int b = 0; b < 2; ++b)
#pragma unroll
                for (int m = 0; m < 4; ++m)
#pragma unroll
                    for (int n = 0; n < 2; ++n) acc[a][b][m][n] = (f32x4){0.f, 0.f, 0.f, 0.f};
        cur = nxt; cA = nA; cB = nB; ++ui;
        if constexpr (ALIGN_EPI) { if (wr == 1) PG8_BAR; }
    }
    PG8_WAIT_V(0);
    if constexpr (!ALIGN_EPI) { if (wr == 0) PG8_BAR; }
    PG8_BAR;
#undef PG8_SA
#undef PG8_SB
#undef PG8_STAGE
#undef PG8_LDA
#undef PG8_LDB
#undef PG8_MMA
#undef PG8_WAIT_V
#undef PG8_WAIT_L
#undef PG8_BAR
#undef PG8_SCHED
}

struct UnitX { int pm, pn, seg; };
template <class Prog>
__device__ __forceinline__ void gemm_stream(LAS unsigned char* lds, const Prog& P, int wave_s) {
    const int tid = fresh_tid(wave_s);
    const int wid = __builtin_amdgcn_readfirstlane(tid >> 6), lane = tid & 63, wr = wid >> 2, wc = wid & 3, fr = lane & 15, fq = lane >> 4;
    unsigned r2A[2], r2B[2], c2[2];
#pragma unroll
    for (int i = 0; i < 2; ++i) { int R, C; stage_rc(tid * 16 + i * 8192, R, C); const int Rb = (R & ~31) + perm32(R & 31); r2A[i] = 2u * R; r2B[i] = 2u * Rb; c2[i] = 2u * C; }
    const size_t kstep = (size_t)(BK * 2);
    const unsigned ldsw = (unsigned)wid * 1024u;
    const int aoff = lds_byte(wr * 64 + fr, fq * 8), boff = lds_byte(wc * 32 + fr, fq * 8);
#define GS_SA(b, h) (((b) * 2 + (h)) * HTB)
#define GS_SB(b, h) ((4 + (b) * 2 + (h)) * HTB)
#define GS_STAGE(bufoff, gbase, r2, Kx) do { _Pragma("unroll") for (int _i = 0; _i < 2; ++_i) \
        __builtin_amdgcn_global_load_lds((const unsigned*)((const char*)(gbase) + ((r2)[_i] * (unsigned)(Kx) + c2[_i])), (LAS unsigned*)(lds + (bufoff) + ldsw + _i * 8192), 16, 0, 0); } while (0)
#define GS_LDA(dst, b, h) do { _Pragma("unroll") for (int m = 0; m < 4; ++m) _Pragma("unroll") for (int k = 0; k < 2; ++k) dst[m][k] = *(const LAS bf16x8*)(lds + GS_SA(b, h) + aoff + m * 2048 + k * 1024); } while (0)
#define GS_LDB(dst, b, h) do { _Pragma("unroll") for (int n = 0; n < 2; ++n) _Pragma("unroll") for (int k = 0; k < 2; ++k) dst[n][k] = *(const LAS bf16x8*)(lds + GS_SB(b, h) + boff + n * 2048 + k * 1024); } while (0)
#define GS_MMA(ai, bj, At, Bt) do { __builtin_amdgcn_s_setprio(1); _Pragma("unroll") for (int m = 0; m < 4; ++m) _Pragma("unroll") for (int n = 0; n < 2; ++n) _Pragma("unroll") for (int k = 0; k < 2; ++k) \
        acc[ai][bj][m][n] = __builtin_amdgcn_mfma_f32_16x16x32_bf16(Bt[n][k], At[m][k], acc[ai][bj][m][n], 0, 0, 0); __builtin_amdgcn_s_setprio(0); } while (0)
#define GS_WAIT_V(n) asm volatile("s_waitcnt vmcnt(" #n ")" ::: "memory")
#define GS_WAIT_L(n) asm volatile("s_waitcnt lgkmcnt(" #n ")" ::: "memory")
#define GS_BAR __builtin_amdgcn_s_barrier()
#define GS_SCHED __builtin_amdgcn_sched_barrier(0)
    UnitX cur, nxt; int ui = 0;
    if (!P.next(0, cur)) return;
    f32x4 acc[2][2][4][2];
#pragma unroll
    for (int a = 0; a < 2; ++a)
#pragma unroll
        for (int b = 0; b < 2; ++b)
#pragma unroll
            for (int m = 0; m < 4; ++m)
#pragma unroll
                for (int n = 0; n < 2; ++n) acc[a][b][m][n] = (f32x4){0.f, 0.f, 0.f, 0.f};
    bf16x8 At[4][2], B0[2][2], B1[2][2];
    const bf16_t* gA; const bf16_t* gB; int Kc;
    P.desc(cur.seg, gA, gB, Kc);
    size_t hc = (size_t)HALF * Kc * 2;
    const char* cA = (const char*)gA + (size_t)cur.pm * 2 * hc; const char* cB = (const char*)gB + (size_t)cur.pn * 2 * hc;
    GS_STAGE(GS_SB(0, 0), cB, r2B, Kc); GS_STAGE(GS_SB(0, 1), cB + hc, r2B, Kc); GS_STAGE(GS_SA(0, 0), cA, r2A, Kc); GS_STAGE(GS_SA(0, 1), cA + hc, r2A, Kc);
    if (wr == 1) GS_BAR;
    GS_WAIT_V(2); GS_BAR;
    GS_STAGE(GS_SB(1, 0), cB + kstep, r2B, Kc); GS_STAGE(GS_SA(1, 0), cA + kstep, r2A, Kc); GS_STAGE(GS_SB(1, 1), cB + hc + kstep, r2B, Kc);
    GS_WAIT_V(6); GS_BAR;
    for (;;) {
        const bool has_next = P.next(ui + 1, nxt);
        const bf16_t* nAg = gA; const bf16_t* nBg = gB; int Kn = Kc;
        if (has_next) P.desc(nxt.seg, nAg, nBg, Kn);
        const size_t hn = (size_t)HALF * Kn * 2;
        const char* nA = has_next ? (const char*)nAg + (size_t)nxt.pm * 2 * hn : cA; const char* nB = has_next ? (const char*)nBg + (size_t)nxt.pn * 2 * hn : cB;
        const int nt = Kc / BK;
        for (int t = 0; t < nt; t += 2) {
            const bool last = (t == nt - 2);
            const char* a1 = cA + (size_t)(t + 1) * kstep;
            const char* a2 = last ? nA : cA + (size_t)(t + 2) * kstep; const char* b2 = last ? nB : cB + (size_t)(t + 2) * kstep;
            const char* a3 = a2 + kstep; const char* b3 = b2 + kstep;
            int K2 = last ? Kn : Kc; size_t h2 = last ? hn : hc;
            asm volatile("" : "+s"(a1), "+s"(a2), "+s"(b2), "+s"(a3), "+s"(b3));
            GS_LDB(B0, 0, 0); GS_LDB(B1, 0, 1); GS_SCHED; GS_LDA(At, 0, 0); GS_STAGE(GS_SA(1, 1), a1 + hc, r2A, Kc);
            GS_WAIT_V(8); GS_WAIT_L(0); GS_BAR; GS_MMA(0, 0, At, B0); GS_MMA(0, 1, At, B1); GS_BAR; GS_SCHED;
            GS_LDA(At, 0, 1); GS_STAGE(GS_SB(0, 0), b2, r2B, K2); GS_STAGE(GS_SB(0, 1), b2 + h2, r2B, K2); GS_STAGE(GS_SA(0, 0), a2, r2A, K2);
            GS_WAIT_V(8); GS_WAIT_L(0); GS_BAR; GS_MMA(1, 0, At, B0); GS_MMA(1, 1, At, B1); GS_BAR; GS_SCHED;
            GS_LDB(B0, 1, 0); GS_LDB(B1, 1, 1); GS_SCHED; GS_LDA(At, 1, 0); GS_STAGE(GS_SA(0, 1), a2 + h2, r2A, K2);
            GS_WAIT_V(8); GS_WAIT_L(0); GS_BAR; GS_MMA(0, 0, At, B0); GS_MMA(0, 1, At, B1); GS_BAR; GS_SCHED;
            GS_LDA(At, 1, 1); GS_STAGE(GS_SB(1, 0), b3, r2B, K2); GS_STAGE(GS_SB(1, 1), b3 + h2, r2B, K2); GS_STAGE(GS_SA(1, 0), a3, r2A, K2);
            GS_WAIT_V(8); GS_WAIT_L(0); GS_BAR; GS_MMA(1, 0, At, B0); GS_MMA(1, 1, At, B1); GS_BAR; GS_SCHED;
        }
        if (wr == 0) GS_BAR;
        P.epi(cur.seg, acc, cur, wr, wc, fr, fq);
        if (!has_next) break;
#pragma unroll
        for (int a = 0; a < 2; ++a)
#pragma unroll
            for (int b = 0; b < 2; ++b)
#pragma unroll
                for (int m = 0; m < 4; ++m)
#pragma unroll
                    for (int n = 0; n < 2; ++n) acc[a][b][m][n] = (f32x4){0.f, 0.f, 0.f, 0.f};
        cur = nxt; cA = nA; cB = nB; gA = nAg; gB = nBg; Kc = Kn; hc = hn; ++ui;
        if (wr == 1) GS_BAR;
    }
    GS_WAIT_V(0);
    GS_BAR;
#undef GS_SA
#undef GS_SB
#undef GS_STAGE
#undef GS_LDA
#undef GS_LDB
#undef GS_MMA
#undef GS_WAIT_V
#undef GS_WAIT_L
#undef GS_BAR
#undef GS_SCHED
}
}
using pg8::Unit;
typedef f32x4 Acc[2][2][4][2];

#define EPI_ROWS_BEGIN  _Pragma("unroll") for (int ai = 0; ai < 2; ++ai) _Pragma("unroll") for (int m = 0; m < 4; ++m) { const size_t row = (size_t)(row0 + ai * 128 + m * 16);
#define EPI_ROWS_END    if (m & 1) asm volatile("" ::: "memory"); }

struct EpiSwiglu { static constexpr bool PERM = true;
    bf16_t* H; const float* ssq;
    __device__ __forceinline__ void operator()(const Acc& acc, const Unit& u, int wr, int wc, int fr, int fq) const {
        { const int t_ = fresh_lane(); fr = t_ & 15; fq = (t_ >> 4) & 3; }
        const int row0 = u.pm * 256 + wr * 64 + fr, col0 = u.pn * 128 + wc * 32 + 8 * fq;
        float rs8[8]; rstd8<16>(rs8, ssq, row0, fq, 1.0f / 1024.0f);
        EPI_ROWS_BEGIN
            const float rstd = rs8[ai * 4 + m];
            f32x4 hv[2];
#pragma unroll
            for (int n = 0; n < 2; ++n) { const f32x4 g = acc[ai][0][m][n] * rstd, up = acc[ai][1][m][n] * rstd;
#pragma unroll
                for (int e = 0; e < 4; ++e) { const float sg = __builtin_amdgcn_rcpf(1.0f + __builtin_amdgcn_exp2f(-1.4426950408889634f * g[e])); hv[n][e] = g[e] * sg * up[e]; } }
            __builtin_nontemporal_store(pack8(hv[0], hv[1]), (u32x4*)(H + row * DFF + col0));
        EPI_ROWS_END
    }
};
struct EpiResid { static constexpr bool PERM = true;
    bf16_t* XB; float* SSQ; float scale;
    __device__ __forceinline__ void operator()(const Acc& acc, const Unit& u, int wr, int wc, int fr, int fq) const {
        { const int t_ = fresh_lane(); fr = t_ & 15; fq = (t_ >> 4) & 3; }
        const int row0 = u.pm * 256 + wr * 64 + fr, col0 = u.pn * 256 + wc * 32 + 8 * fq;
        EPI_ROWS_BEGIN
            float s = 0.f;
#pragma unroll
            for (int bj = 0; bj < 2; ++bj) { bf16_t* xp = XB + row * DM + col0 + bj * 128;
                const u32x4 w = *(const u32x4*)xp;
                f32x4 x0 = {bf2f(w.x & 0xffffu), bf2f(w.x >> 16), bf2f(w.y & 0xffffu), bf2f(w.y >> 16)}, x1 = {bf2f(w.z & 0xffffu), bf2f(w.z >> 16), bf2f(w.w & 0xffffu), bf2f(w.w >> 16)};
                x0 += acc[ai][bj][m][0] * scale; x1 += acc[ai][bj][m][1] * scale;
                *(u32x4*)xp = pack8(x0, x1);
                s += dot4(x0) + dot4(x1); }
            s += __shfl_xor(s, 16); s += __shfl_xor(s, 32);
            if (fq == 0) SSQ[row * 16 + u.pn * 4 + wc] = s;
        EPI_ROWS_END
    }
};
struct EpiIn { static constexpr bool PERM = true;
    const float* ssqx; bf16_t* XPOOL; bf16_t* KVLAT; bf16_t* QLAT; bf16_t* KROPE; float* SSQQ; float* SSQKV; const float* CS;
    __device__ __forceinline__ void operator()(const Acc& acc, const Unit& u, int wr, int wc, int fr, int fq) const {
        { const int t_ = fresh_lane(); fr = t_ & 15; fq = (t_ >> 4) & 3; }
        const int row0 = u.pm * 256 + wr * 64 + fr, lc = wc * 32 + 8 * fq, pn = u.pn;
        float rs8[8]; rstd8<16>(rs8, ssqx, row0, fq, 1.0f / 1024.0f);
        if (pn < 2) {
            EPI_ROWS_BEGIN
                const float rstd = rs8[ai * 4 + m];
#pragma unroll
                for (int bj = 0; bj < 2; ++bj) *(u32x4*)(XPOOL + row * 512 + pn * 256 + bj * 128 + lc) = pack8(acc[ai][bj][m][0] * rstd, acc[ai][bj][m][1] * rstd);
            EPI_ROWS_END
        } else if (pn < 4) {
            bf16_t* dst = (pn == 2) ? KVLAT : QLAT; const int ld = (pn == 2) ? 256 : 384; float* sq = (pn == 2) ? SSQKV : SSQQ; const int sld = (pn == 2) ? 4 : 8;
            EPI_ROWS_BEGIN
                const float rstd = rs8[ai * 4 + m];
                float s = 0.f;
#pragma unroll
                for (int bj = 0; bj < 2; ++bj) { const f32x4 v0 = acc[ai][bj][m][0] * rstd, v1 = acc[ai][bj][m][1] * rstd;
                    *(u32x4*)(dst + row * ld + bj * 128 + lc) = pack8(v0, v1); s += dot4(v0) + dot4(v1); }
                s += __shfl_xor(s, 16); s += __shfl_xor(s, 32);
                if (fq == 0) sq[row * sld + wc] = s;
            EPI_ROWS_END
        } else {
            EPI_ROWS_BEGIN
                const float rstd = rs8[ai * 4 + m];
                const f32x4 v0 = acc[ai][0][m][0] * rstd, v1 = acc[ai][0][m][1] * rstd;
                *(u32x4*)(QLAT + row * 384 + 256 + lc) = pack8(v0, v1);
                float s = dot4(v0) + dot4(v1);
                s += __shfl_xor(s, 16); s += __shfl_xor(s, 32);
                if (fq == 0) SSQQ[row * 8 + 4 + wc] = s;
                if (wc < 2) {
                    const int i0 = 16 * wc + 4 * fq;
                    const f32x4 c01 = *(const f32x4*)(CS + (row * 32 + i0) * 2), c23 = *(const f32x4*)(CS + (row * 32 + i0) * 2 + 4);
                    const f32x4 cs = {c01[0], c01[2], c23[0], c23[2]}, sn = {c01[1], c01[3], c23[1], c23[3]};
                    const f32x4 x1 = acc[ai][1][m][0] * rstd, x2 = acc[ai][1][m][1] * rstd;
                    const f32x4 o1 = x1 * cs - x2 * sn, o2 = x2 * cs + x1 * sn;
                    u32x2 w1, w2; w1.x = pk2(o1[0], o1[1]); w1.y = pk2(o1[2], o1[3]); w2.x = pk2(o2[0], o2[1]); w2.y = pk2(o2[2], o2[3]);
                    *(u32x2*)(KROPE + row * 64 + i0) = w1; *(u32x2*)(KROPE + row * 64 + 32 + i0) = w2;
                }
            EPI_ROWS_END
        }
    }
};
struct EpiGate { static constexpr bool PERM = true;
    const float* ssqx; const float* bias; bf16_t* G;
    __device__ __forceinline__ void operator()(const Acc& acc, const Unit& u, int wr, int wc, int fr, int fq) const {
        { const int t_ = fresh_lane(); fr = t_ & 15; fq = (t_ >> 4) & 3; }
        const int row0 = u.pm * 256 + wr * 64 + fr, col0 = u.pn * 256 + wc * 32 + 8 * fq;
        f32x4 bv[2][2];
#pragma unroll
        for (int bj = 0; bj < 2; ++bj)
#pragma unroll
            for (int n = 0; n < 2; ++n) bv[bj][n] = *(const f32x4*)(bias + col0 + bj * 128 + 4 * n);
        float rs8[8]; rstd8<16>(rs8, ssqx, row0, fq, 1.0f / 1024.0f);
        EPI_ROWS_BEGIN
            const float rstd = rs8[ai * 4 + m];
#pragma unroll
            for (int bj = 0; bj < 2; ++bj) { f32x4 gv[2];
#pragma unroll
                for (int n = 0; n < 2; ++n) { const f32x4 z = acc[ai][bj][m][n] * rstd + bv[bj][n];
#pragma unroll
                    for (int e = 0; e < 4; ++e) gv[n][e] = __builtin_rintf(255.0f * __builtin_amdgcn_rcpf(1.0f + __builtin_amdgcn_exp2f(-1.4426950408889634f * z[e]))); }
                u32x2 w; w.x = 0u; w.y = 0u;
#pragma unroll
                for (int e = 0; e < 4; ++e) { w.x = __builtin_amdgcn_cvt_pk_u8_f32(gv[0][e], e, w.x); w.y = __builtin_amdgcn_cvt_pk_u8_f32(gv[1][e], e, w.y); }
                *(u32x2*)((unsigned char*)G + row * DM + col0 + bj * 128) = w; }
        EPI_ROWS_END
    }
};
template <int MODE> struct EpiGated { static constexpr bool PERM = true;
    const bf16_t* G; bf16_t* MB;
    __device__ __forceinline__ void operator()(const Acc& acc, const Unit& u, int wr, int wc, int fr, int fq) const {
        { const int t_ = fresh_lane(); fr = t_ & 15; fq = (t_ >> 4) & 3; }
        const int row0 = u.pm * 256 + wr * 64 + fr, col0 = u.pn * 256 + wc * 32 + 8 * fq;
        EPI_ROWS_BEGIN
#pragma unroll
            for (int bj = 0; bj < 2; ++bj) { const size_t off = row * DM + col0 + bj * 128;
                const u32x2 gw = *(const u32x2*)((const unsigned char*)G + off);
                const float k255 = 1.0f / 255.0f;
                f32x4 g0 = {(float)(gw.x & 0xffu) * k255, (float)((gw.x >> 8) & 0xffu) * k255, (float)((gw.x >> 16) & 0xffu) * k255, (float)(gw.x >> 24) * k255};
                f32x4 g1 = {(float)(gw.y & 0xffu) * k255, (float)((gw.y >> 8) & 0xffu) * k255, (float)((gw.y >> 16) & 0xffu) * k255, (float)(gw.y >> 24) * k255};
                f32x4 r0 = g0 * acc[ai][bj][m][0], r1 = g1 * acc[ai][bj][m][1];
                if (MODE == 1) { const u32x4 mw = *(const u32x4*)(MB + off);
                    r0 += (f32x4){bf2f(mw.x & 0xffffu), bf2f(mw.x >> 16), bf2f(mw.y & 0xffffu), bf2f(mw.y >> 16)}; r1 += (f32x4){bf2f(mw.z & 0xffffu), bf2f(mw.z >> 16), bf2f(mw.w & 0xffffu), bf2f(mw.w >> 16)}; }
                *(u32x4*)(MB + off) = pack8(r0, r1); }
        EPI_ROWS_END
    }
};
struct EpiPlain { static constexpr bool PERM = true;
    bf16_t* O; int ldc;
    __device__ __forceinline__ void operator()(const Acc& acc, const Unit& u, int wr, int wc, int fr, int fq) const {
        { const int t_ = fresh_lane(); fr = t_ & 15; fq = (t_ >> 4) & 3; }
        const int row0 = u.pm * 256 + wr * 64 + fr, col0 = u.pn * 256 + wc * 32 + 8 * fq;
        EPI_ROWS_BEGIN
#pragma unroll
            for (int bj = 0; bj < 2; ++bj) *(u32x4*)(O + row * ldc + col0 + bj * 128) = pack8(acc[ai][bj][m][0], acc[ai][bj][m][1]);
        EPI_ROWS_END
    }
};
struct EpiQ { static constexpr bool PERM = true;
    const float* ssqq; const float* CS; bf16_t* QB;
    __device__ __forceinline__ void operator()(const Acc& acc, const Unit& u, int wr, int wc, int fr, int fq) const {
        { const int t_ = fresh_lane(); fr = t_ & 15; fq = (t_ >> 4) & 3; }
        const int row0 = u.pm * 256 + wr * 64 + fr, pn = u.pn;
        float rs8[8]; rstd8<8>(rs8, ssqq, row0, fq, 1.0f / 384.0f);
        if (pn < 4) {
            EPI_ROWS_BEGIN
                const float rs = rs8[ai * 4 + m] * QSCALE;
                bf16_t* qp = QB + row * 1536 + (2 * pn) * 192 + wc * 32 + 8 * fq;
                *(u32x4*)qp = pack8(acc[ai][0][m][0] * rs, acc[ai][0][m][1] * rs);
                *(u32x4*)(qp + 192) = pack8(acc[ai][1][m][0] * rs, acc[ai][1][m][1] * rs);
            EPI_ROWS_END
        } else {
            const int i0 = 16 * (wc & 1) + 4 * fq, head0 = 4 * (pn - 4) + (wc >> 1);
            EPI_ROWS_BEGIN
                const float rs = rs8[ai * 4 + m] * QSCALE;
                const f32x4 c01 = *(const f32x4*)(CS + (row * 32 + i0) * 2), c23 = *(const f32x4*)(CS + (row * 32 + i0) * 2 + 4);
                const f32x4 cs = {c01[0] * rs, c01[2] * rs, c23[0] * rs, c23[2] * rs}, sn = {c01[1] * rs, c01[3] * rs, c23[1] * rs, c23[3] * rs};
                bf16_t* qp = QB + row * 1536 + head0 * 192 + 128 + i0;
#pragma unroll
                for (int bj = 0; bj < 2; ++bj) {
                    const f32x4 x1 = acc[ai][bj][m][0], x2 = acc[ai][bj][m][1];
                    const f32x4 o1 = x1 * cs - x2 * sn, o2 = x2 * cs + x1 * sn;
                    u32x2 w1, w2; w1.x = pk2(o1[0], o1[1]); w1.y = pk2(o1[2], o1[3]); w2.x = pk2(o2[0], o2[1]); w2.y = pk2(o2[2], o2[3]);
                    *(u32x2*)(qp + bj * 384) = w1; *(u32x2*)(qp + bj * 384 + 32) = w2; }
            EPI_ROWS_END
        }
    }
};
struct EpiKV { static constexpr bool PERM = true;
    const float* ssqkv; bf16_t* KN; bf16_t* VT; LAS unsigned char* scr;
    __device__ __forceinline__ void operator()(const Acc& acc, const Unit& u, int wr, int wc, int fr, int fq) const {
        const int lane = fresh_lane(); fr = lane & 15; fq = (lane >> 4) & 3;
        const int row0 = u.pm * 256 + wr * 64 + fr, lc = wc * 32 + 8 * fq, pn = u.pn;
        const int pfr = (fr & 3) | ((fr & 4) << 1) | ((fr & 8) >> 1);
        float rs8[8]; rstd8<4>(rs8, ssqkv, row0, fq, 1.0f / 256.0f);
        EPI_ROWS_BEGIN
            const float rs = rs8[ai * 4 + m];
            *(u32x4*)(KN + row * 1024 + pn * 128 + lc) = pack8(acc[ai][0][m][0] * rs, acc[ai][0][m][1] * rs);
        EPI_ROWS_END
        LAS unsigned char* my = scr + (wr * 4 + wc) * 2816;
        const int rrow = lane >> 2, rc2 = lane & 3;
#pragma unroll
        for (int ai = 0; ai < 2; ++ai) {
            const int rbase = u.pm * 256 + ai * 128 + wr * 64, b = rbase >> 11, s0 = rbase & 2047;
#pragma unroll
            for (int n = 0; n < 2; ++n) {
#pragma unroll
                for (int m = 0; m < 4; ++m) { const float rs = rs8[ai * 4 + m];
#pragma unroll
                    for (int e = 0; e < 4; ++e) *(LAS bf16_t*)(my + (4 * fq + e) * 176 + (16 * m + pfr) * 2) = (bf16_t)(pk2(acc[ai][1][m][n][e] * rs, 0.f) & 0xffffu); }
                asm volatile("s_waitcnt lgkmcnt(0)" ::: "memory");
                const u32x4 v0 = *(const LAS u32x4*)(my + rrow * 176 + rc2 * 32), v1 = *(const LAS u32x4*)(my + rrow * 176 + rc2 * 32 + 16);
                const int d = 32 * wc + 8 * (rrow >> 2) + 4 * n + (rrow & 3);
                bf16_t* vp = VT + ((size_t)(b * 8 + pn) * 128 + d) * 2048 + s0 + rc2 * 16;
                *(u32x4*)vp = v0; *(u32x4*)(vp + 8) = v1;
                asm volatile("s_waitcnt lgkmcnt(0)" ::: "memory");
            }
        }
    }
};


struct ProgMerge {
    pg8::StaticOrder S; int n;
    const bf16_t* XB; const bf16_t* MIXED; const bf16_t* AO; const bf16_t* Wg; const bf16_t* Wpp; const bf16_t* Wap;
    EpiGate EA, EB; EpiGated<0> E0; EpiGated<1> E1;
    __device__ __forceinline__ bool next(int i, pg8::UnitX& u) const {
        int seg = 0, j = i; while (j >= n && seg < 4) { j -= n; ++seg; }
        if (seg >= 4 || n <= 0) return false;
        Unit uu; if (!S.next(j, uu)) return false;
        u.pm = uu.pm; u.pn = uu.pn; u.seg = seg; return true;
    }
    __device__ __forceinline__ void desc(int seg, const bf16_t*& A, const bf16_t*& Bt, int& K) const {
        if (seg == 0) { A = XB; Bt = Wg; K = 1024; }
        else if (seg == 1) { A = MIXED; Bt = Wpp; K = 512; }
        else if (seg == 2) { A = XB; Bt = Wg + (size_t)1024 * 1024; K = 1024; }
        else { A = AO; Bt = Wap; K = 1024; }
    }
    __device__ __forceinline__ void epi(int seg, const Acc& acc, const pg8::UnitX& ux, int wr, int wc, int fr, int fq) const {
        const Unit u{ux.pm, ux.pn};
        if (seg == 0) EA(acc, u, wr, wc, fr, fq);
        else if (seg == 1) E0(acc, u, wr, wc, fr, fq);
        else if (seg == 2) EB(acc, u, wr, wc, fr, fq);
        else E1(acc, u, wr, wc, fr, fq);
    }
};

namespace att {
constexpr int KROW = 400, VROW = 144;
constexpr int KBUF = 64 * KROW, VBUF = 128 * VROW;
constexpr int OFF_K = 0, OFF_V = 2 * KBUF, LDS_BYTES = 2 * KBUF + 2 * VBUF;
__device__ __forceinline__ int crow(int r, int hi) { return (r & 3) + 8 * (r >> 2) + 4 * hi; }
#define MFMA32(a, b, c) __builtin_amdgcn_mfma_f32_32x32x16_bf16((a), (b), (c), 0, 0, 0)

__device__ __forceinline__ void attn_unit(LAS unsigned char* L, int b, int h, int qb, const bf16_t* QB, const bf16_t* KN, const bf16_t* KR, const bf16_t* VT, bf16_t* AO, int wave_s) {
    const int tid = fresh_tid(wave_s);
    const int lane = tid & 63, wid = __builtin_amdgcn_readfirstlane(tid >> 6), q = lane & 31, hi = lane >> 5;
    const int rowbase = b * SEQ, q0 = qb * 256, myq0 = q0 + 32 * wid, NT = (q0 + 256) >> 6;
    const int kr0 = tid >> 4, kc0 = tid & 15;
    const int rr = tid >> 3, rc = tid & 7;
    const bf16_t* kn_src = KN + (size_t)(rowbase + kr0) * 1024 + h * 128 + kc0 * 8;
    const bf16_t* kr_src = KR + (size_t)(rowbase + rr) * 64 + rc * 8;
    const bf16_t* vt_src = VT + ((size_t)(b * 8 + h) * 128 + rr) * 2048 + rc * 8;
    const int kn_dst = kr0 * KROW + kc0 * 16, kr_dst = rr * KROW + 256 + rc * 16, vt_dst = rr * VROW + rc * 16;
    u32x4 sk0, sk1, sk2, sv0, sv1;
#define ATT_LOAD_K(kt) do { sk0 = *(const u32x4*)(kn_src + (size_t)(kt) * 64 * 1024); sk1 = *(const u32x4*)(kn_src + (size_t)(kt) * 64 * 1024 + 32 * 1024); \
        sk2 = *(const u32x4*)(kr_src + (size_t)(kt) * 64 * 64); } while (0)
#define ATT_LOAD_V(kt) do { sv0 = *(const u32x4*)(vt_src + (kt) * 64); sv1 = *(const u32x4*)(vt_src + (size_t)64 * 2048 + (kt) * 64); } while (0)
#define ATT_STORE_K(buf) do { LAS unsigned char* kb_ = L + OFF_K + (buf) * KBUF; \
        *(LAS u32x4*)(kb_ + kn_dst) = sk0; *(LAS u32x4*)(kb_ + kn_dst + 32 * KROW) = sk1; *(LAS u32x4*)(kb_ + kr_dst) = sk2; } while (0)
#define ATT_STORE_V(buf) do { LAS unsigned char* vb_ = L + OFF_V + (buf) * VBUF; \
        *(LAS u32x4*)(vb_ + vt_dst) = sv0; *(LAS u32x4*)(vb_ + vt_dst + 64 * VROW) = sv1; } while (0)
    ATT_LOAD_K(0); ATT_LOAD_V(0);
    bf16x8 qf[12];
    { const bf16_t* qp = QB + (size_t)(rowbase + myq0 + q) * 1536 + h * 192 + 8 * hi;
#pragma unroll
      for (int d0 = 0; d0 < 12; ++d0) qf[d0] = *(const bf16x8*)(qp + 16 * d0); }
    f32x16 o[4];
#pragma unroll
    for (int dt = 0; dt < 4; ++dt)
#pragma unroll
        for (int r = 0; r < 16; ++r) o[dt][r] = 0.f;
    float mrun = -1e30f, lrun = 0.f;
    ATT_STORE_K(0); ATT_STORE_V(0);
    ATT_LOAD_K(1);
    __syncthreads();
#define END_EVEN(kt) do { if ((kt) + 1 < NT) { ATT_STORE_K(((kt) + 1) & 1); ATT_LOAD_V((kt) + 1); } } while (0)
#define END_ODD(kt)  do { if ((kt) + 1 < NT) ATT_STORE_V(((kt) + 1) & 1); if ((kt) + 2 < NT) ATT_LOAD_K((kt) + 2); } while (0)
#define SB_() __builtin_amdgcn_sched_barrier(0)
#define X_BODY(kt) \
    f32x16 p0, p1; \
    { const LAS unsigned char* kb = L + OFF_K + ((kt) & 1) * KBUF + q * KROW + hi * 16; \
      _Pragma("unroll") for (int r = 0; r < 16; ++r) { p0[r] = 0.f; p1[r] = 0.f; } \
      bf16x8 ka[3][2]; \
      ka[0][0] = *(const LAS bf16x8*)(kb); ka[0][1] = *(const LAS bf16x8*)(kb + 32 * KROW); \
      ka[1][0] = *(const LAS bf16x8*)(kb + 32); ka[1][1] = *(const LAS bf16x8*)(kb + 32 * KROW + 32); \
      ka[2][0] = *(const LAS bf16x8*)(kb + 64); ka[2][1] = *(const LAS bf16x8*)(kb + 32 * KROW + 64); \
      SB_(); \
      _Pragma("unroll") for (int d0 = 0; d0 < 12; ++d0) { \
          p0 = MFMA32(ka[d0 % 3][0], qf[d0], p0); p1 = MFMA32(ka[d0 % 3][1], qf[d0], p1); \
          SB_(); \
          if (d0 + 3 < 12) { ka[d0 % 3][0] = *(const LAS bf16x8*)(kb + (d0 + 3) * 32); ka[d0 % 3][1] = *(const LAS bf16x8*)(kb + 32 * KROW + (d0 + 3) * 32); SB_(); } } \
      if ((kt) * 64 + 63 > myq0) { const int qi = myq0 + q, kbase = (kt) * 64; \
          _Pragma("unroll") for (int r = 0; r < 16; ++r) { const int key = kbase + crow(r, hi); if (key > qi) p0[r] = -1e30f; if (key + 32 > qi) p1[r] = -1e30f; } } \
      float mx = p0[0]; \
      _Pragma("unroll") for (int r = 1; r < 16; ++r) mx = fmaxf(mx, p0[r]); \
      _Pragma("unroll") for (int r = 0; r < 16; ++r) mx = fmaxf(mx, p1[r]); \
      { const auto rr_ = __builtin_amdgcn_permlane32_swap(__float_as_uint(mx), __float_as_uint(mx), false, false);        \
        mx = fmaxf(__uint_as_float(rr_[0]), __uint_as_float(rr_[1])); } \
      if (__any(mx > mrun + 8.0f)) { const float mnew = fmaxf(mrun, mx), alpha = __builtin_amdgcn_exp2f(mrun - mnew); \
          lrun *= alpha; \
          _Pragma("unroll") for (int dt = 0; dt < 4; ++dt) _Pragma("unroll") for (int r = 0; r < 16; ++r) o[dt][r] *= alpha; \
          mrun = mnew; } }
#define Y_BODY(kt) \
    { const LAS unsigned char* vb = L + OFF_V + ((kt) & 1) * VBUF + q * VROW + hi * 16; \
      bf16x8 va[4]; \
      _Pragma("unroll") for (int i_ = 0; i_ < 4; ++i_) va[i_] = *(const LAS bf16x8*)(vb + i_ * 32 * VROW); \
      SB_(); \
      float ls = 0.f; \
      _Pragma("unroll") for (int r = 0; r < 16; ++r) { p0[r] = __builtin_amdgcn_exp2f(p0[r] - mrun); p1[r] = __builtin_amdgcn_exp2f(p1[r] - mrun); ls += p0[r] + p1[r]; } \
      lrun += ls; \
      bf16x8 pf[4]; \
      { u32x4 w; \
        w.x = pk2(p0[0], p0[1]); w.y = pk2(p0[2], p0[3]); w.z = pk2(p0[4], p0[5]); w.w = pk2(p0[6], p0[7]); pf[0] = __builtin_bit_cast(bf16x8, w); \
        w.x = pk2(p0[8], p0[9]); w.y = pk2(p0[10], p0[11]); w.z = pk2(p0[12], p0[13]); w.w = pk2(p0[14], p0[15]); pf[1] = __builtin_bit_cast(bf16x8, w); \
        w.x = pk2(p1[0], p1[1]); w.y = pk2(p1[2], p1[3]); w.z = pk2(p1[4], p1[5]); w.w = pk2(p1[6], p1[7]); pf[2] = __builtin_bit_cast(bf16x8, w); \
        w.x = pk2(p1[8], p1[9]); w.y = pk2(p1[10], p1[11]); w.z = pk2(p1[12], p1[13]); w.w = pk2(p1[14], p1[15]); pf[3] = __builtin_bit_cast(bf16x8, w); } \
      SB_(); \
      _Pragma("unroll") for (int i_ = 0; i_ < 16; ++i_) {            \
          o[i_ & 3] = MFMA32(va[i_ & 3], pf[i_ >> 2], o[i_ & 3]); \
          SB_(); \
          if (i_ + 4 < 16) { va[i_ & 3] = *(const LAS bf16x8*)(vb + ((i_ + 4) & 3) * 32 * VROW + ((i_ + 4) >> 2) * 32); SB_(); } } }
    if (wid >= 4) __builtin_amdgcn_s_setprio(1);
    const int grp = wid >> 2, ktmax = (myq0 + 31) >> 6, nact = (ktmax + 1 < NT) ? ktmax + 1 : NT;
    if (grp == 0) {
        int kt = 0;
        for (; kt < nact; ++kt) {
            X_BODY(kt) END_EVEN(kt); __syncthreads();
            Y_BODY(kt) END_ODD(kt); __syncthreads();
        }
        for (; kt < NT; ++kt) { END_EVEN(kt); __syncthreads(); END_ODD(kt); __syncthreads(); }
        __syncthreads();
    } else {
        END_EVEN(0); __syncthreads();
        int kt = 0;
        for (; kt < nact; ++kt) {
            X_BODY(kt) END_ODD(kt); __syncthreads();
            Y_BODY(kt) END_EVEN(kt + 1); __syncthreads();
        }
        for (; kt < NT; ++kt) { END_ODD(kt); __syncthreads(); END_EVEN(kt + 1); __syncthreads(); }
    }
#undef END_EVEN
#undef END_ODD
#undef X_BODY
#undef SB_
#undef Y_BODY
    __builtin_amdgcn_s_setprio(0);
    float lt;
    { const auto rr_ = __builtin_amdgcn_permlane32_swap(__float_as_uint(lrun), __float_as_uint(lrun), false, false); lt = __uint_as_float(rr_[0]) + __uint_as_float(rr_[1]); }
    const float inv = 1.0f / lt;
    bf16_t* op = AO + (size_t)(rowbase + myq0 + q) * 1024 + h * 128 + 8 * hi;
#pragma unroll
    for (int dt = 0; dt < 4; ++dt)
#pragma unroll
        for (int p = 0; p < 2; ++p) {
            unsigned ax = pk2(o[dt][8 * p] * inv, o[dt][8 * p + 1] * inv), ay = pk2(o[dt][8 * p + 2] * inv, o[dt][8 * p + 3] * inv);
            unsigned bx_ = pk2(o[dt][8 * p + 4] * inv, o[dt][8 * p + 5] * inv), by_ = pk2(o[dt][8 * p + 6] * inv, o[dt][8 * p + 7] * inv);
            { auto r = __builtin_amdgcn_permlane32_swap(ax, bx_, false, false); ax = r[0]; bx_ = r[1]; }
            { auto r = __builtin_amdgcn_permlane32_swap(ay, by_, false, false); ay = r[0]; by_ = r[1]; }
            u32x4 w; w.x = ax; w.y = ay; w.z = bx_; w.w = by_;
            *(u32x4*)(op + 32 * dt + 16 * p) = w; }
#undef ATT_LOAD_K
#undef ATT_LOAD_V
#undef ATT_STORE_K
#undef ATT_STORE_V
}
}

struct Params {
    const float* x; const int* pos; const float* norm_ffn1; const float* ffn1_up; const float* ffn1_down; const float* norm_mix; const float* w_in; const float* b_gate;
    const float* pool_maps; const float* pool_scale; const float* w_pool_proj; const float* q_latent_norm; const float* w_uq; const float* kv_latent_norm; const float* w_ukv;
    const float* w_attn_proj; const float* w_out; const float* norm_ffn2; const float* ffn2_up; const float* ffn2_down; const float* final_norm;
    float* out; unsigned char* ws; int ph_lo, ph_hi;
};
constexpr int NPH_LAYER = 10, NPH = DEPTH * NPH_LAYER + 1;
constexpr int LDS_EXTRA = 131072 + 256;
constexpr int LDS_BYTES = LDS_EXTRA + 8 * 2816;

__device__ const float INVF[32] = {1.000000000e+00f, 7.498942093e-01f, 5.623413252e-01f, 4.216965034e-01f, 3.162277660e-01f, 2.371373706e-01f, 1.778279410e-01f, 1.333521432e-01f,
    1.000000000e-01f, 7.498942093e-02f, 5.623413252e-02f, 4.216965034e-02f, 3.162277660e-02f, 2.371373706e-02f, 1.778279410e-02f, 1.333521432e-02f,
    1.000000000e-02f, 7.498942093e-03f, 5.623413252e-03f, 4.216965034e-03f, 3.162277660e-03f, 2.371373706e-03f, 1.778279410e-03f, 1.333521432e-03f,
    1.000000000e-03f, 7.498942093e-04f, 5.623413252e-04f, 4.216965034e-04f, 3.162277660e-04f, 2.371373706e-04f, 1.778279410e-04f, 1.333521432e-04f};

__device__ __forceinline__ float wave_sum(float v) {
#pragma unroll
    for (int o = 1; o < 64; o <<= 1) v += __shfl_xor(v, o);
    return v;
}
#define LDS_WAIT() asm volatile("s_waitcnt lgkmcnt(0)" ::: "memory")

template <int MAP> __device__ __forceinline__ void conv_mat(const float* src, int ld, int K, int Np, int col0, bf16_t* dst, const float* rscale, const float* aux, LAS float* scr, int gw, int NGW, int lane, int& rot) {
    const int nblk = Np / 32, nitems = (K / 64) * nblk;
    int it0 = gw - rot; if (it0 < 0) it0 += NGW;
    rot = (rot + nitems) % NGW;
    for (int it = it0; it < nitems; it += NGW) {
        const int kb = it / nblk, nb = it % nblk, k0 = 64 * kb, n0 = 32 * nb, np = n0 + (lane & 31);
        int col = np + col0, kbase = k0, sld = ld; bool valid = true; float cs = 1.f; const float* sp = src;
        if (MAP == 1) { const int t = np >> 8, half = (np >> 7) & 1, j = np & 127; col = half * DFF + t * 128 + j; }
        if (MAP == 2) {
            if (np < 512) col = np;
            else if (np < 768) col = 896 + (np - 512);
            else if (np < 1152) col = 512 + (np - 768);
            else if (np < 1216) { const int c = np - 1152, n = (c >> 2) & 1, e = c & 3, fq = (c >> 3) & 3, wc = c >> 5; col = 1152 + 16 * wc + 4 * fq + e + 32 * n; }
            else { col = 0; valid = false; }
        }
        if (MAP == 4) {
            if (np < 1024) col = (np >> 7) * 192 + (np & 127);
            else { const int r = np - 1024, head = r >> 6, n = (r >> 2) & 1, e = r & 3, fq = (r >> 3) & 3, wcl = (r >> 5) & 1; col = head * 192 + 128 + 16 * wcl + 4 * fq + e + 32 * n; }
        }
        if (MAP == 5) { const int g = np >> 7; valid = ((k0 >> 7) == g); sp = src + g * 16384; sld = 128; kbase = k0 & 127; col = np & 127; cs = aux[np]; }
        float cv[32];
#pragma unroll
        for (int i = 0; i < 32; ++i) { const int kk = 2 * i + (lane >> 5); cv[i] = valid ? __builtin_nontemporal_load(sp + (size_t)(kbase + kk) * sld + col) : 0.f; }
#pragma unroll
        for (int i = 0; i < 32; ++i) { const int kk = 2 * i + (lane >> 5);
            float v = cv[i];
            if (rscale) v *= rscale[k0 + kk];
            scr[kk * 33 + (lane & 31)] = v * cs; }
        LDS_WAIT(); asm volatile("" ::: "memory");
        const int c = lane & 7;
#pragma unroll
        for (int j = 0; j < 4; ++j) { const int n = (lane >> 3) + 8 * j; const LAS float* s = scr + (8 * c) * 33 + n;
            u32x4 o; o.x = pk2(s[0 * 33], s[1 * 33]); o.y = pk2(s[2 * 33], s[3 * 33]); o.z = pk2(s[4 * 33], s[5 * 33]); o.w = pk2(s[6 * 33], s[7 * 33]);
            *(u32x4*)(dst + (size_t)(n0 + n) * K + k0 + 8 * c) = o; }
        LDS_WAIT(); asm volatile("" ::: "memory");
    }
}


#define XB_TMO      128
#define XB_XCNT(j)  (256  + 64 * (j))
#define XB_XSUB(j)  (1280 + 64 * (j))
#define XB_XGEN(j)  (2304 + 64 * (j))
#define XB_TOP      3328
#define XB_TOPGEN   3392
#define XCD_BAR_WORDS 3456
#define XB_SPIN_CAP (1u << 22)
__device__ __forceinline__ unsigned xb_ld(unsigned* p)              { return __hip_atomic_load(p, __ATOMIC_RELAXED, __HIP_MEMORY_SCOPE_AGENT); }
__device__ __forceinline__ unsigned xb_add(unsigned* p, unsigned v) { return __hip_atomic_fetch_add(p, v, __ATOMIC_RELAXED, __HIP_MEMORY_SCOPE_AGENT); }
__device__ __forceinline__ unsigned xb_xcc_id() { return (unsigned)__builtin_amdgcn_s_getreg((3 << 11) | 20) & 0xFu; }
#define XB_SPIN(cond, bar) do { unsigned _sp = 0; while (cond) { __builtin_amdgcn_s_sleep(1); \
    if ((++_sp & 255u) == 0u) { if (xb_ld(&(bar)[XB_TMO])) break; if (_sp > XB_SPIN_CAP) { atomicAdd(&(bar)[XB_TMO], 1u); break; } } } } while (0)
__device__ __forceinline__ void xcd_barrier_complete(unsigned* bar, unsigned x, unsigned& nloc, unsigned& nx) {
    const unsigned G = gridDim.x * gridDim.y * gridDim.z;
    unsigned sum, cnt, mine, sp = 0u;
    for (;;) {
        sum = 0u; cnt = 0u; mine = 0u;
#pragma unroll
        for (unsigned j = 0; j < 16; ++j) { const unsigned c = xb_ld(&bar[XB_XCNT(j)]); sum += c; cnt += (c > 0u) ? 1u : 0u; mine = (j == x) ? c : mine; }
        if (sum == G) break;
        __builtin_amdgcn_s_sleep(1);
        if ((++sp & 255u) == 0u) { if (xb_ld(&bar[XB_TMO])) break; if (sp > XB_SPIN_CAP) { atomicAdd(&bar[XB_TMO], 1u); break; } }
    }
    nloc = mine > 0u ? mine : 1u; nx = cnt > 0u ? cnt : 1u;
}
__device__ __forceinline__ void xcd_barrier(unsigned* bar, volatile LAS unsigned* st, int wave_s) {
    asm volatile("s_waitcnt vmcnt(0)" ::: "memory");
    __syncthreads();
    if (wave_s == 0 && fresh_lane() == 0) {
        const unsigned x = xb_xcc_id();
        __builtin_amdgcn_s_waitcnt(0);
        unsigned nloc = st[0], nx = st[1];
        if (nloc == 0u) { xcd_barrier_complete(bar, x, nloc, nx); st[0] = nloc; st[1] = nx; }
        const unsigned old = xb_add(&bar[XB_XSUB(x)], 1u);
        const unsigned gen = old / nloc;
        if (old + 1u == (gen + 1u) * nloc) {
            __builtin_amdgcn_fence(__ATOMIC_RELEASE, "agent");
            asm volatile("s_waitcnt vmcnt(0)" ::: "memory");
            const unsigned og = xb_add(&bar[XB_TOP], 1u);
            const unsigned tg = og / nx;
            if (og + 1u == (tg + 1u) * nx) xb_add(&bar[XB_TOPGEN], 1u);
            else XB_SPIN(xb_ld(&bar[XB_TOPGEN]) == tg, bar);
            __builtin_amdgcn_fence(__ATOMIC_ACQUIRE, "agent");
            xb_add(&bar[XB_XGEN(x)], 1u);
            asm volatile("s_waitcnt vmcnt(0)" ::: "memory");
        } else {
            XB_SPIN(xb_ld(&bar[XB_XGEN(x)]) == gen, bar);
            __builtin_amdgcn_fence(__ATOMIC_ACQUIRE, "agent");
            asm volatile("s_waitcnt vmcnt(0)" ::: "memory");
        }
    }
    __syncthreads();
}

typedef const __attribute__((address_space(4))) unsigned long long* kargp_t;
__device__ __forceinline__ unsigned long long karg(int idx) { kargp_t kp = (kargp_t)__builtin_amdgcn_kernarg_segment_ptr(); asm volatile("" : "+s"(kp)); return kp[idx]; }
#define GAS __attribute__((address_space(1)))
#define KF(idx) ((const float*)(const GAS float*)karg(idx))
enum { A_X = 0, A_POS, A_NORM_FFN1, A_FFN1_UP, A_FFN1_DOWN, A_NORM_MIX, A_W_IN, A_B_GATE, A_POOL_MAPS, A_POOL_SCALE, A_W_POOL_PROJ, A_Q_NORM, A_W_UQ, A_KV_NORM, A_W_UKV,
       A_W_ATTN_PROJ, A_W_OUT, A_NORM_FFN2, A_FFN2_UP, A_FFN2_DOWN, A_FINAL_NORM, A_OUT, A_WS, A_PH };


__device__ __forceinline__ void comb_pool_mat(const float* maps, const float* scale, const float* wpp, bf16_t* dst, LAS float* scr, int gw, int NGW, int lane, int& rot) {
    const int nitems = 4 * 16 * 16;
    int it0 = gw - rot; if (it0 < 0) it0 += NGW;
    rot = (rot + nitems) % NGW;
    LAS f32x4* scr4 = (LAS f32x4*)scr;
    for (int it = it0; it < nitems; it += NGW) {
        const int g = it >> 8, cb = (it >> 4) & 15, nb = it & 15, c0 = cb * 8, n = nb * 64 + lane;
        { const f32x4* m4 = (const f32x4*)(maps + (size_t)g * 16384 + (size_t)c0 * 128);
#pragma unroll
          for (int i = 0; i < 4; ++i) scr4[lane + 64 * i] = m4[lane + 64 * i]; }
        LDS_WAIT(); asm volatile("" ::: "memory");
        float a[8];
#pragma unroll
        for (int j = 0; j < 8; ++j) a[j] = 0.f;
        const float* wcol = wpp + (size_t)(g * 128) * 1024 + n;
        const f32x4* s4p = (const f32x4*)(scale + g * 128);
#pragma unroll 2
        for (int d4 = 0; d4 < 32; ++d4) {
            const f32x4 s4 = s4p[d4];
            const float w0 = wcol[(size_t)(4 * d4) * 1024] * s4[0], w1 = wcol[(size_t)(4 * d4 + 1) * 1024] * s4[1], w2 = wcol[(size_t)(4 * d4 + 2) * 1024] * s4[2], w3 = wcol[(size_t)(4 * d4 + 3) * 1024] * s4[3];
#pragma unroll
            for (int j = 0; j < 8; ++j) { const f32x4 m = scr4[j * 32 + d4]; a[j] += (m[0] * w0 + m[1] * w1) + (m[2] * w2 + m[3] * w3); }
        }
        u32x4 o; o.x = pk2(a[0], a[1]); o.y = pk2(a[2], a[3]); o.z = pk2(a[4], a[5]); o.w = pk2(a[6], a[7]);
        *(u32x4*)(dst + (size_t)n * 512 + g * 128 + c0) = o;
        LDS_WAIT(); asm volatile("" ::: "memory");
    }
}

__device__ __forceinline__ void conv_layer(int l, bf16_t* Wd, LAS float* scr, int gw, int NGW, int lane) {
    int rot = 0;
    const float* up1 = KF(A_FFN1_UP) + (size_t)l * 1024 * 5632; const float* dn1 = KF(A_FFN1_DOWN) + (size_t)l * 2816 * 1024;
    const float* up2 = KF(A_FFN2_UP) + (size_t)l * 1024 * 5632; const float* dn2 = KF(A_FFN2_DOWN) + (size_t)l * 2816 * 1024;
    const float* win = KF(A_W_IN) + (size_t)l * 1024 * INDIM;
    conv_mat<1>(up1, 5632, 1024, 5632, 0, Wd + W_UP1, KF(A_NORM_FFN1) + l * 1024, nullptr, scr, gw, NGW, lane, rot);
    conv_mat<0>(dn1, 1024, 2816, 1024, 0, Wd + W_DN1, nullptr, nullptr, scr, gw, NGW, lane, rot);
    conv_mat<2>(win, INDIM, 1024, 1280, 0, Wd + W_IN5, KF(A_NORM_MIX) + l * 1024, nullptr, scr, gw, NGW, lane, rot);
    conv_mat<0>(win, INDIM, 1024, 2048, 1216, Wd + W_G, KF(A_NORM_MIX) + l * 1024, nullptr, scr, gw, NGW, lane, rot);
    comb_pool_mat(KF(A_POOL_MAPS) + (size_t)l * 4 * 128 * 128, KF(A_POOL_SCALE) + l * 512, KF(A_W_POOL_PROJ) + (size_t)l * 512 * 1024, Wd + W_PP, scr, gw, NGW, lane, rot);
    conv_mat<4>(KF(A_W_UQ) + (size_t)l * 384 * 1536, 1536, 384, 1536, 0, Wd + W_UQ, KF(A_Q_NORM) + l * 384, nullptr, scr, gw, NGW, lane, rot);
    conv_mat<0>(KF(A_W_UKV) + (size_t)l * 256 * 2048, 2048, 256, 2048, 0, Wd + W_UKV, KF(A_KV_NORM) + l * 256, nullptr, scr, gw, NGW, lane, rot);
    conv_mat<0>(KF(A_W_ATTN_PROJ) + (size_t)l * 1024 * 1024, 1024, 1024, 1024, 0, Wd + W_AP, nullptr, nullptr, scr, gw, NGW, lane, rot);
    conv_mat<0>(KF(A_W_OUT) + (size_t)l * 1024 * 1024, 1024, 1024, 1024, 0, Wd + W_WO, nullptr, nullptr, scr, gw, NGW, lane, rot);
    conv_mat<1>(up2, 5632, 1024, 5632, 0, Wd + W_UP2, KF(A_NORM_FFN2) + l * 1024, nullptr, scr, gw, NGW, lane, rot);
    conv_mat<0>(dn2, 1024, 2816, 1024, 0, Wd + W_DN2, nullptr, nullptr, scr, gw, NGW, lane, rot);
}

__global__ void __launch_bounds__(512, 2) mk_fwd(Params p_unused) {
    extern __shared__ __attribute__((aligned(16))) unsigned char lds_raw[];
    cg::grid_group grid = cg::this_grid();
    LAS unsigned char* lds = (LAS unsigned char*)lds_raw;
#define PHASE_IDS \
    const int tid = fresh_tid(wave_s); int bx = blockIdx.x; asm volatile("" : "+s"(bx)); int G = gridDim.x; asm volatile("" : "+s"(G)); \
    const int lane = tid & 63, wave = __builtin_amdgcn_readfirstlane(tid >> 6); \
    const int vcu = (G % 8 == 0) ? (bx % 8) * (G / 8) + bx / 8 : bx;         \
    const int gw = vcu * 8 + wave, NGW = G * 8; (void)lane; (void)gw; (void)NGW;
#define WS_PTRS \
    unsigned char* ws = (unsigned char*)(GAS unsigned char*)karg(A_WS); \
    bf16_t* Wl = (l & 1) ? (bf16_t*)(GAS bf16_t*)karg(A_OUT) : (bf16_t*)(ws + WS_W); bf16_t* XB = (bf16_t*)(ws + WS_XB); \
    float* SSQX = (float*)(ws + WS_SSQX); float* SSQQ = (float*)(ws + WS_SSQQ); float* SSQKV = (float*)(ws + WS_SSQKV); float* CS = (float*)(ws + WS_CS); \
    unsigned char* big = ws + WS_BIG; \
    bf16_t* H = (bf16_t*)(big + B_H * MiB); \
    bf16_t* QB = (bf16_t*)(big + B_QB * MiB); bf16_t* KN = (bf16_t*)(big + B_KN * MiB); bf16_t* VT = (bf16_t*)(big + B_VT * MiB); bf16_t* KR = (bf16_t*)(big + B_KR * MiB); \
    bf16_t* POOLED = (bf16_t*)(big + B_POOLED * MiB); bf16_t* AO = (bf16_t*)(big + B_AO * MiB); bf16_t* MIXED = (bf16_t*)(big + B_MIXED * MiB); \
    bf16_t* XPOOL = (bf16_t*)(big + B_XPOOL * MiB); bf16_t* KVLAT = (bf16_t*)(big + B_KVLAT * MiB); bf16_t* QLAT = (bf16_t*)(big + B_QLAT * MiB); \
    bf16_t* GT = (bf16_t*)(big + B_G * MiB); bf16_t* MB = (bf16_t*)(big + B_MB * MiB); \
    float* X = (float*)(GAS float*)karg(A_OUT); \
    (void)Wl; (void)XB; (void)SSQX; (void)SSQQ; (void)SSQKV; (void)CS; (void)H; (void)QB; (void)KN; (void)VT; (void)KR; (void)POOLED; (void)AO; (void)MIXED; (void)XPOOL; (void)KVLAT; (void)QLAT; (void)GT; (void)MB; (void)X;
    const unsigned long long phw = karg(A_PH); const int ph_lo = (int)(unsigned)phw, ph_hi = (int)(unsigned)(phw >> 32);
    volatile LAS unsigned* bst = (volatile LAS unsigned*)(lds + 131072 + 64);
    const int wave_s = __builtin_amdgcn_readfirstlane((int)threadIdx.x >> 6);
    if (wave_s == 0) ((LAS unsigned*)(lds + 131072))[fresh_lane()] = 0u;
    __syncthreads();
    if (wave_s == 0 && fresh_lane() == 0) { unsigned* bar0 = (unsigned*)(GAS unsigned*)karg(A_WS); (void)xb_add(&bar0[XB_XCNT(xb_xcc_id())], 1u); }
    for (int ph = ph_lo; ph < ph_hi; ++ph) {
        if (ph > 0 && ph < NPH - 1 && (ph % NPH_LAYER) == 0) continue;
        if (ph > ph_lo) { if (ph == ph_lo + 1) grid.sync(); else xcd_barrier((unsigned*)(GAS unsigned*)karg(A_WS), bst, wave_s); }
        const int l = ph / NPH_LAYER, k = (ph == NPH - 1) ? 10 : ph % NPH_LAYER;
#ifdef PROBE_DOUBLE
        const int nrep = ((PROBE_DOUBLE >> k) & 1) ? 2 : 1;
        for (int rep = 0; rep < nrep; ++rep) { if (rep) xcd_barrier((unsigned*)(GAS unsigned*)karg(A_WS), bst, wave_s);
        const float rscale = rep ? 0.f : 1.f;
#else
        const float rscale = 1.f;
        {
#endif
        if (k == 0) { PHASE_IDS WS_PTRS
            LAS float* scr = (LAS float*)(lds + wave * 16384);
            conv_layer(0, Wl, scr, gw, NGW, lane);
            if (l == 0) {
                for (int m = gw; m < M; m += NGW) {
                    const f32x4* xr = (const f32x4*)(KF(A_X) + (size_t)m * DM) + lane; f32x4 v[4]; float s = 0.f;
#pragma unroll
                    for (int j = 0; j < 4; ++j) { v[j] = __builtin_nontemporal_load(xr + 64 * j); s += dot4(v[j]); }
                    s = wave_sum(s);
                    u32x2* xb = (u32x2*)(XB + (size_t)m * DM) + lane;
#pragma unroll
                    for (int j = 0; j < 4; ++j) { u32x2 w; w.x = pk2(v[j][0], v[j][1]); w.y = pk2(v[j][2], v[j][3]); xb[64 * j] = w; }
                    if (lane < 16) SSQX[(size_t)m * 16 + lane] = (lane == 0) ? s : 0.f;
                    if (lane < 32) { const float ang = (float)((const int*)(const GAS int*)karg(A_POS))[m] * INVF[lane];
                        const double rev = (double)ang * 0.15915494309189533577; const float fr = (float)(rev - __builtin_rint(rev));
                        f32x2_t cs2 = {__builtin_amdgcn_cosf(fr), __builtin_amdgcn_sinf(fr)};
                        *(f32x2_t*)(CS + ((size_t)m * 32 + lane) * 2) = cs2; }
                }
            }
            __syncthreads();
        } else if (k == 1 || k == 8) { PHASE_IDS WS_PTRS
            pg8::Gemm g{XB, Wl + (k == 1 ? W_UP1 : W_UP2), M, 5632, 1024}; pg8::StaticOrder S; S.init(M, 5632, G, bx);
            EpiSwiglu E{H, SSQX};
            pg8::gemm_phase<EpiSwiglu>(lds, g, S, E, wave_s);
        } else if (k == 2 || k == 9) { PHASE_IDS WS_PTRS
            pg8::Gemm g{H, Wl + (k == 2 ? W_DN1 : W_DN2), M, 1024, 2816}; pg8::StaticOrder S; S.init(M, 1024, G, bx);
            EpiResid E{XB, SSQX, 0.5f * rscale};
            pg8::gemm_phase<EpiResid>(lds, g, S, E, wave_s);
        } else if (k == 3) { PHASE_IDS WS_PTRS
            pg8::Gemm g{XB, Wl + W_IN5, M, 1280, 1024}; pg8::StaticOrder S; S.init(M, 1280, G, bx);
            EpiIn E{SSQX, XPOOL, KVLAT, QLAT, KR, SSQQ, SSQKV, CS};
            pg8::gemm_phase<EpiIn>(lds, g, S, E, wave_s);
            if (l + 1 < DEPTH) {
                const int rem = S.nwg % G, nidle = rem ? G - rem : G, me = rem ? bx - rem : bx;
                if (me >= 0) { bf16_t* Wn = ((l + 1) & 1) ? (bf16_t*)(GAS bf16_t*)karg(A_OUT) : (bf16_t*)(ws + WS_W);
                    conv_layer(l + 1, Wn, (LAS float*)(lds + wave * 16384), me * 8 + wave, nidle * 8, lane); }
                __syncthreads();
            }
        } else if (k == 4) { PHASE_IDS WS_PTRS
            { const int nthr = G * 512, gt = vcu * 512 + tid;
              for (int idx = gt; idx < M * 64; idx += nthr) {
                  const int row = idx >> 6, ch = idx & 63, s = row & (SEQ - 1), w = 2 << (ch >> 4), cnt = (s + 1 < w) ? s + 1 : w;
                  const bf16_t* xp = XPOOL + (size_t)row * 512 + ch * 8;
                  float a[8];
#pragma unroll
                  for (int e = 0; e < 8; ++e) a[e] = 0.f;
                  u32x4 wv[16];
#pragma unroll
                  for (int j = 0; j < 16; ++j) wv[j] = (j < cnt) ? *(const u32x4*)(xp - (size_t)j * 512) : (u32x4){0u, 0u, 0u, 0u};
                  const u32x4 self = wv[0];
#pragma unroll
                  for (int j = 0; j < 16; ++j) { const u32x4 v = wv[j];
                      a[0] += bf2f(v.x & 0xffffu); a[1] += bf2f(v.x >> 16); a[2] += bf2f(v.y & 0xffffu); a[3] += bf2f(v.y >> 16);
                      a[4] += bf2f(v.z & 0xffffu); a[5] += bf2f(v.z >> 16); a[6] += bf2f(v.w & 0xffffu); a[7] += bf2f(v.w >> 16); }
                  const float ic = 1.0f / (float)cnt;
                  u32x4 o;
                  o.x = pk2(a[0] * ic - bf2f(self.x & 0xffffu), a[1] * ic - bf2f(self.x >> 16)); o.y = pk2(a[2] * ic - bf2f(self.y & 0xffffu), a[3] * ic - bf2f(self.y >> 16));
                  o.z = pk2(a[4] * ic - bf2f(self.z & 0xffffu), a[5] * ic - bf2f(self.z >> 16)); o.w = pk2(a[6] * ic - bf2f(self.w & 0xffffu), a[7] * ic - bf2f(self.w >> 16));
                  *(u32x4*)(POOLED + (size_t)row * 512 + ch * 8) = o;
              } }
            { pg8::Gemm g{QLAT, Wl + W_UQ, M, 1536, QLR}; pg8::StaticOrder S; S.init(M, 1536, G, bx);
              EpiQ E{SSQQ, CS, QB};
              pg8::gemm_phase<EpiQ>(lds, g, S, E, wave_s); }
            { pg8::Gemm g{KVLAT, Wl + W_UKV, M, 2048, KVLR}; pg8::StaticOrder S; S.init(M, 2048, G, bx);
              EpiKV E{SSQKV, KN, VT, lds + LDS_EXTRA};
              pg8::gemm_phase<EpiKV>(lds, g, S, E, wave_s); }
        } else if (k == 5) { PHASE_IDS WS_PTRS
            for (int kk = vcu; kk < 256; kk += G)
                for (int i = 0; i < 2; ++i) { const int id = 2 * kk + i, bh = id >> 2, s = id & 3;
                    att::attn_unit(lds, bh >> 3, bh & 7, s, QB, KN, KR, VT, AO, wave_s);
                    att::attn_unit(lds, bh >> 3, bh & 7, 7 - s, QB, KN, KR, VT, AO, wave_s); }
        } else if (k == 6) { PHASE_IDS WS_PTRS
            const float* bg = KF(A_B_GATE) + (size_t)l * 2048;
            ProgMerge P;
            P.S.init(M, 1024, G, bx); P.n = (P.S.nwg > bx) ? (P.S.nwg - bx + G - 1) / G : 0;
            P.XB = XB; P.MIXED = POOLED; P.AO = AO; P.Wg = Wl + W_G; P.Wpp = Wl + W_PP; P.Wap = Wl + W_AP;
            P.EA = EpiGate{SSQX, bg, GT}; P.EB = EpiGate{SSQX, bg + 1024, GT}; P.E0 = EpiGated<0>{GT, MB}; P.E1 = EpiGated<1>{GT, MB};
            pg8::gemm_stream<ProgMerge>(lds, P, wave_s);
        } else if (k == 7) { PHASE_IDS WS_PTRS
            pg8::Gemm g{MB, Wl + W_WO, M, 1024, 1024}; pg8::StaticOrder S; S.init(M, 1024, G, bx);
            EpiResid E{XB, SSQX, 1.0f * rscale};
            pg8::gemm_phase<EpiResid>(lds, g, S, E, wave_s);
        } else { PHASE_IDS WS_PTRS
            for (int m = gw; m < M; m += NGW) {
                f32x4* xr = (f32x4*)(X + (size_t)m * DM) + lane; const u32x2* xb = (const u32x2*)(XB + (size_t)m * DM) + lane; const f32x4* gr = (const f32x4*)KF(A_FINAL_NORM) + lane; f32x4 v[4]; float s = 0.f;
#pragma unroll
                for (int j = 0; j < 4; ++j) { const u32x2 w = xb[64 * j]; v[j] = (f32x4){bf2f(w.x & 0xffffu), bf2f(w.x >> 16), bf2f(w.y & 0xffffu), bf2f(w.y >> 16)}; s += dot4(v[j]); }
                const float rstd = __builtin_amdgcn_rsqf(wave_sum(s) * (1.0f / 1024.0f) + EPS);
#pragma unroll
                for (int j = 0; j < 4; ++j) __builtin_nontemporal_store(v[j] * rstd * gr[64 * j], xr + 64 * j);
            }
        }
        }
    }
}

#ifndef MK_ONE_LAUNCH
#define MK_ONE_LAUNCH 1
#endif
extern "C" void kernel_launch(void* const* d_in, const int* in_sizes, int n_in, void* d_out, int out_size, void* d_ws, size_t ws_size, hipStream_t stream) {
    static int grid = 0;
    if (grid == 0) {
        if (n_in != 21 || in_sizes[0] != M * DM || out_size != M * DM || ws_size < WS_END) {
            fprintf(stderr, "kernel_launch: unexpected shapes (n_in %d, in0 %d, out %d, ws %zu need %zu); nothing launched\n", n_in, n_in > 0 ? in_sizes[0] : -1, out_size, ws_size, (size_t)WS_END);
            grid = -1; return; }
        int dev = 0, cus = 0, per_cu = 0;
        if (hipGetDevice(&dev) != hipSuccess || hipDeviceGetAttribute(&cus, hipDeviceAttributeMultiprocessorCount, dev) != hipSuccess) { grid = -1; return; }
        if (hipFuncSetAttribute((const void*)mk_fwd, hipFuncAttributeMaxDynamicSharedMemorySize, LDS_BYTES) != hipSuccess) { fprintf(stderr, "kernel_launch: hipFuncSetAttribute failed\n"); grid = -1; return; }
        if (hipOccupancyMaxActiveBlocksPerMultiprocessor(&per_cu, (const void*)mk_fwd, 512, LDS_BYTES) != hipSuccess || per_cu < 1) { fprintf(stderr, "kernel_launch: occupancy query says %d\n", per_cu); per_cu = 1; }
        (void)hipGetLastError();
        grid = cus * per_cu;
    }
    if (grid < 0) return;
    if (hipMemsetAsync(d_ws, 0, 16384, stream) != hipSuccess) { fprintf(stderr, "kernel_launch: memset of the barrier words failed\n"); return; }
    Params p{};
    p.x = (const float*)d_in[0]; p.pos = (const int*)d_in[1]; p.norm_ffn1 = (const float*)d_in[2]; p.ffn1_up = (const float*)d_in[3]; p.ffn1_down = (const float*)d_in[4];
    p.norm_mix = (const float*)d_in[5]; p.w_in = (const float*)d_in[6]; p.b_gate = (const float*)d_in[7]; p.pool_maps = (const float*)d_in[8]; p.pool_scale = (const float*)d_in[9];
    p.w_pool_proj = (const float*)d_in[10]; p.q_latent_norm = (const float*)d_in[11]; p.w_uq = (const float*)d_in[12]; p.kv_latent_norm = (const float*)d_in[13]; p.w_ukv = (const float*)d_in[14];
    p.w_attn_proj = (const float*)d_in[15]; p.w_out = (const float*)d_in[16]; p.norm_ffn2 = (const float*)d_in[17]; p.ffn2_up = (const float*)d_in[18]; p.ffn2_down = (const float*)d_in[19];
    p.final_norm = (const float*)d_in[20];
    p.out = (float*)d_out; p.ws = (unsigned char*)d_ws;
#if MK_ONE_LAUNCH
    p.ph_lo = 0; p.ph_hi = NPH;
    void* args[] = {&p};
    hipError_t e = hipLaunchCooperativeKernel((const void*)mk_fwd, dim3(grid), dim3(512), args, LDS_BYTES, stream);
    if (e != hipSuccess) fprintf(stderr, "kernel_launch: cooperative launch failed: %s (grid %d)\n", hipGetErrorString(e), grid);
#else
    for (int ph = 0; ph < NPH; ++ph) { p.ph_lo = ph; p.ph_hi = ph + 1; hipLaunchKernelGGL(mk_fwd, dim3(grid), dim3(512), LDS_BYTES, stream, p); }
#endif
}
```

```cpp
#include <hip/hip_runtime.h>
#include <hip/hip_cooperative_groups.h>
#include <cstdio>
#include <cstdint>
namespace cg = cooperative_groups;

#define LAS __attribute__((address_space(3)))
typedef unsigned short bf16_t;
typedef short bf16x8 __attribute__((ext_vector_type(8)));
typedef float f32x4 __attribute__((ext_vector_type(4)));
typedef float f32x16 __attribute__((ext_vector_type(16)));
typedef unsigned u32x4 __attribute__((ext_vector_type(4)));
typedef unsigned u32x2 __attribute__((ext_vector_type(2)));
typedef float f32x2_t __attribute__((ext_vector_type(2)));
typedef __bf16 bf16x2_t __attribute__((ext_vector_type(2)));


__device__ __forceinline__ int fresh_lane() { int l; asm volatile("v_mbcnt_lo_u32_b32 %0, -1, 0\n\tv_mbcnt_hi_u32_b32 %0, -1, %0" : "=v"(l)); return l; }
__device__ __forceinline__ int fresh_tid(int wave_s) { return (wave_s << 6) | fresh_lane(); }

constexpr int BATCH = 16, SEQ = 2048, DM = 1024, DEPTH = 4, NH = 8, DFF = 2816;
constexpr int M = BATCH * SEQ;
constexpr int QLR = 384, KVLR = 256, INDIM = 3264;
constexpr float EPS = 1e-6f;
constexpr float QSCALE = 0.07216878364870322f * 1.4426950408889634f;

constexpr size_t W_UP1 = 0;
constexpr size_t W_DN1 = W_UP1 + (size_t)5632 * 1024;
constexpr size_t W_IN5 = W_DN1 + (size_t)1024 * 2816;
constexpr size_t W_G   = W_IN5 + (size_t)1280 * 1024;
constexpr size_t W_PM  = W_G + (size_t)2048 * 1024;
constexpr size_t W_PP  = W_PM + (size_t)512 * 512;
constexpr size_t W_UQ  = W_PP + (size_t)1024 * 512;
constexpr size_t W_UKV = W_UQ + (size_t)1536 * 384;
constexpr size_t W_AP  = W_UKV + (size_t)2048 * 256;
constexpr size_t W_WO  = W_AP + (size_t)1024 * 1024;
constexpr size_t W_UP2 = W_WO + (size_t)1024 * 1024;
constexpr size_t W_DN2 = W_UP2 + (size_t)5632 * 1024;
constexpr size_t W_END = W_DN2 + (size_t)1024 * 2816;

constexpr size_t MiB = 1u << 20;
constexpr size_t WS_W = 1 * MiB;
static_assert(W_END * 2 <= 48 * MiB, "weight region");
constexpr size_t WS_XB = 49 * MiB;
constexpr size_t WS_SSQX = 113 * MiB;
constexpr size_t WS_SSQQ = 115 * MiB;
constexpr size_t WS_SSQKV = 116 * MiB;
constexpr size_t WS_CS = 117 * MiB;
constexpr size_t WS_BIG = 125 * MiB;
constexpr size_t WS_END = WS_BIG + 356 * MiB;
constexpr size_t B_H = 0;
constexpr size_t B_QB = 0, B_KN = 96, B_VT = 160, B_KR = 224, B_POOLED = 228, B_AO = 260, B_MIXED = 324;
constexpr size_t B_XPOOL = 260, B_KVLAT = 292, B_QLAT = 308;
constexpr size_t B_G = 0, B_MB = 64;

__device__ __forceinline__ unsigned pk2(float lo, float hi) { f32x2_t v = {lo, hi}; bf16x2_t b = __builtin_convertvector(v, bf16x2_t); return __builtin_bit_cast(unsigned, b); }
__device__ __forceinline__ u32x4 pack8(f32x4 a, f32x4 b) { u32x4 w; w.x = pk2(a[0], a[1]); w.y = pk2(a[2], a[3]); w.z = pk2(b[0], b[1]); w.w = pk2(b[2], b[3]); return w; }
__device__ __forceinline__ float bf2f(unsigned bits16) { return __uint_as_float(bits16 << 16); }
__device__ __forceinline__ float dot4(f32x4 a) { return (a[0] * a[0] + a[1] * a[1]) + (a[2] * a[2] + a[3] * a[3]); }
template <int NP> __device__ __forceinline__ float rstd_from(const float* p, float inv_n) {
    float s = 0.f;
#pragma unroll
    for (int i = 0; i < NP / 4; ++i) { const f32x4 v = *(const f32x4*)(p + 4 * i); s += (v[0] + v[1]) + (v[2] + v[3]); }
    return __builtin_amdgcn_rsqf(s * inv_n + EPS);
}


template <int NP> __device__ __forceinline__ void rstd8(float (&rs)[8], const float* ssq, int row0, int fq, float inv_n) {
    constexpr int PER = NP / 4;
    float s[8];
#pragma unroll
    for (int i = 0; i < 8; ++i) { const float* p = ssq + (size_t)(row0 + (i >> 2) * 128 + (i & 3) * 16) * NP + PER * fq;
        if (PER == 4) { const f32x4 v = *(const f32x4*)p; s[i] = (v[0] + v[1]) + (v[2] + v[3]); }
        else if (PER == 2) { const f32x2_t v = *(const f32x2_t*)p; s[i] = v[0] + v[1]; }
        else s[i] = *p; }
#pragma unroll
    for (int i = 0; i < 8; ++i) { float t = s[i]; t += __shfl_xor(t, 16); t += __shfl_xor(t, 32); rs[i] = __builtin_amdgcn_rsqf(t * inv_n + EPS); }
}

namespace pg8 {
constexpr int BM = 256, BK = 64, HALF = 128, HTB = HALF * BK * 2, STAGE_BYTES = 8 * HTB, NXCD = 8, WGM = 8;
__host__ __device__ __forceinline__ int lds_byte(int r, int c) { const int st = (r >> 4) * 2 + (c >> 5), rr = r & 15, cc = c & 31, ob = rr * 64 + cc * 2; return st * 1024 + (ob ^ (((ob >> 9) & 1) << 5)); }
__host__ __device__ __forceinline__ void stage_rc(int b, int& R, int& C) { const int st = b / 1024, sb = b % 1024, swz = sb ^ (((sb >> 9) & 1) << 5); R = (st >> 1) * 16 + swz / 64; C = (st & 1) * 32 + (swz % 64) / 2; }
__host__ __device__ __forceinline__ int perm32(int rho) { const int n = rho >> 4, i = rho & 15; return 8 * (i >> 2) + 4 * n + (i & 3); }

struct Unit { int pm, pn; };
struct Gemm { const bf16_t* A; const bf16_t* Bt; int M, N, K; };

struct StaticOrder {
    int nM, nN, nwg, G, c;
    __device__ void init(int M_, int N_, int G_, int c_) { nM = M_ / BM; nN = N_ / BM; nwg = nM * nN; G = G_; c = c_; }
    __device__ bool next(int i, Unit& u) const {
        const long L = (long)i * G + c; if (L >= nwg) return false;
        int wgid = (int)L; { const int q = nwg / NXCD, r = nwg % NXCD, xcd = wgid % NXCD, off = wgid / NXCD; wgid = (xcd < r ? xcd * (q + 1) : r * (q + 1) + (xcd - r) * q) + off; }
        const int nig = WGM * nN, gid = wgid / nig, fm = gid * WGM, gsz = (nM - fm) < WGM ? (nM - fm) : WGM;
        u.pm = fm + ((wgid % nig) % gsz); u.pn = (wgid % nig) / gsz; return true;
    }
};

template <class Epi, bool ALIGN_EPI = true, bool SP2 = true>
__device__ __forceinline__ void gemm_phase(LAS unsigned char* lds, const Gemm g, const StaticOrder& S, const Epi& E, int wave_s) {
    const int tid = fresh_tid(wave_s);
    const int wid = __builtin_amdgcn_readfirstlane(tid >> 6), lane = tid & 63, wr = wid >> 2, wc = wid & 3, fr = lane & 15, fq = lane >> 4;
    const int K = g.K, nt = K / BK;
    unsigned voffA[2], voffB[2];
#pragma unroll
    for (int i = 0; i < 2; ++i) { int R, C; stage_rc(tid * 16 + i * 8192, R, C); const int Rb = Epi::PERM ? ((R & ~31) + perm32(R & 31)) : R;
        voffA[i] = (unsigned)(R * K + C) * 2u; voffB[i] = (unsigned)(Rb * K + C) * 2u; }
    const size_t kstep = (size_t)(BK * 2);
    const size_t hstep = (size_t)HALF * K * 2;
    const size_t tstep = 2 * hstep;
    const unsigned ldsw = (unsigned)wid * 1024u;
    const int aoff = lds_byte(wr * 64 + fr, fq * 8), boff = lds_byte(wc * 32 + fr, fq * 8);
#define PG8_SA(b, h) (((b) * 2 + (h)) * HTB)
#define PG8_SB(b, h) ((4 + (b) * 2 + (h)) * HTB)
#define PG8_STAGE(bufoff, gbase, voff) do { _Pragma("unroll") for (int _i = 0; _i < 2; ++_i) \
        __builtin_amdgcn_global_load_lds((const unsigned*)((const char*)(gbase) + (voff)[_i]), (LAS unsigned*)(lds + (bufoff) + ldsw + _i * 8192), 16, 0, 0); } while (0)
#define PG8_LDA(dst, b, h) do { _Pragma("unroll") for (int m = 0; m < 4; ++m) _Pragma("unroll") for (int k = 0; k < 2; ++k) dst[m][k] = *(const LAS bf16x8*)(lds + PG8_SA(b, h) + aoff + m * 2048 + k * 1024); } while (0)
#define PG8_LDB(dst, b, h) do { _Pragma("unroll") for (int n = 0; n < 2; ++n) _Pragma("unroll") for (int k = 0; k < 2; ++k) dst[n][k] = *(const LAS bf16x8*)(lds + PG8_SB(b, h) + boff + n * 2048 + k * 1024); } while (0)
#define PG8_MMA(ai, bj, At, Bt) do { __builtin_amdgcn_s_setprio(1); _Pragma("unroll") for (int m = 0; m < 4; ++m) _Pragma("unroll") for (int n = 0; n < 2; ++n) _Pragma("unroll") for (int k = 0; k < 2; ++k) \
        acc[ai][bj][m][n] = __builtin_amdgcn_mfma_f32_16x16x32_bf16(Bt[n][k], At[m][k], acc[ai][bj][m][n], 0, 0, 0); __builtin_amdgcn_s_setprio(0); } while (0)
#define PG8_WAIT_V(n) asm volatile("s_waitcnt vmcnt(" #n ")" ::: "memory")
#define PG8_WAIT_L(n) asm volatile("s_waitcnt lgkmcnt(" #n ")" ::: "memory")
#define PG8_BAR __builtin_amdgcn_s_barrier()
#define PG8_SCHED __builtin_amdgcn_sched_barrier(0)
    Unit cur, nxt; int ui = 0;
    if (!S.next(0, cur)) return;
    f32x4 acc[2][2][4][2];
#pragma unroll
    for (int a = 0; a < 2; ++a)
#pragma unroll
        for (int b = 0; b < 2; ++b)
#pragma unroll
            for (int m = 0; m < 4; ++m)
#pragma unroll
                for (int n = 0; n < 2; ++n) acc[a][b][m][n] = (f32x4){0.f, 0.f, 0.f, 0.f};
    bf16x8 At[4][2], B0[2][2], B1[2][2];
    const char* cA = (const char*)g.A + (size_t)cur.pm * tstep; const char* cB = (const char*)g.Bt + (size_t)cur.pn * tstep;
    if constexpr (SP2) {
        PG8_STAGE(PG8_SB(0, 0), cB, voffB); PG8_STAGE(PG8_SB(0, 1), cB + hstep, voffB); PG8_STAGE(PG8_SA(0, 0), cA, voffA); PG8_STAGE(PG8_SA(0, 1), cA + hstep, voffA);
        if (wr == 1) PG8_BAR;
        PG8_WAIT_V(2); PG8_BAR;
        PG8_STAGE(PG8_SB(1, 0), cB + kstep, voffB); PG8_STAGE(PG8_SA(1, 0), cA + kstep, voffA); PG8_STAGE(PG8_SB(1, 1), cB + hstep + kstep, voffB);
        PG8_WAIT_V(6); PG8_BAR;
    } else {
        PG8_STAGE(PG8_SB(0, 0), cB, voffB); PG8_STAGE(PG8_SA(0, 0), cA, voffA); PG8_STAGE(PG8_SB(0, 1), cB + hstep, voffB); PG8_STAGE(PG8_SA(0, 1), cA + hstep, voffA);
        if (wr == 1) PG8_BAR;
        PG8_WAIT_V(4); PG8_BAR;
        PG8_STAGE(PG8_SB(1, 0), cB + kstep, voffB); PG8_STAGE(PG8_SA(1, 0), cA + kstep, voffA); PG8_STAGE(PG8_SB(1, 1), cB + hstep + kstep, voffB);
        PG8_WAIT_V(6); PG8_BAR;
    }
    for (;;) {
        const bool has_next = S.next(ui + 1, nxt);
        const char* nA = has_next ? (const char*)g.A + (size_t)nxt.pm * tstep : cA; const char* nB = has_next ? (const char*)g.Bt + (size_t)nxt.pn * tstep : cB;
        for (int t = 0; t < nt; t += 2) {
            const bool last = (t == nt - 2);
            const char* a1 = cA + (size_t)(t + 1) * kstep;
            const char* a2 = last ? nA : cA + (size_t)(t + 2) * kstep; const char* b2 = last ? nB : cB + (size_t)(t + 2) * kstep;
            const char* a3 = a2 + kstep; const char* b3 = b2 + kstep;
            asm volatile("" : "+s"(a1), "+s"(a2), "+s"(b2), "+s"(a3), "+s"(b3));
            if constexpr (SP2) {
            PG8_LDB(B0, 0, 0); PG8_LDB(B1, 0, 1); PG8_SCHED; PG8_LDA(At, 0, 0); PG8_STAGE(PG8_SA(1, 1), a1 + hstep, voffA);
            PG8_WAIT_V(8); PG8_WAIT_L(0); PG8_BAR; PG8_MMA(0, 0, At, B0); PG8_MMA(0, 1, At, B1); PG8_BAR; PG8_SCHED;
            PG8_LDA(At, 0, 1); PG8_STAGE(PG8_SB(0, 0), b2, voffB); PG8_STAGE(PG8_SB(0, 1), b2 + hstep, voffB); PG8_STAGE(PG8_SA(0, 0), a2, voffA);
            PG8_WAIT_V(8); PG8_WAIT_L(0); PG8_BAR; PG8_MMA(1, 0, At, B0); PG8_MMA(1, 1, At, B1); PG8_BAR; PG8_SCHED;
            PG8_LDB(B0, 1, 0); PG8_LDB(B1, 1, 1); PG8_SCHED; PG8_LDA(At, 1, 0); PG8_STAGE(PG8_SA(0, 1), a2 + hstep, voffA);
            PG8_WAIT_V(8); PG8_WAIT_L(0); PG8_BAR; PG8_MMA(0, 0, At, B0); PG8_MMA(0, 1, At, B1); PG8_BAR; PG8_SCHED;
            PG8_LDA(At, 1, 1); PG8_STAGE(PG8_SB(1, 0), b3, voffB); PG8_STAGE(PG8_SB(1, 1), b3 + hstep, voffB); PG8_STAGE(PG8_SA(1, 0), a3, voffA);
            PG8_WAIT_V(8); PG8_WAIT_L(0); PG8_BAR; PG8_MMA(1, 0, At, B0); PG8_MMA(1, 1, At, B1); PG8_BAR; PG8_SCHED;
            } else {
            PG8_LDB(B0, 0, 0); PG8_SCHED; PG8_LDA(At, 0, 0); PG8_STAGE(PG8_SA(1, 1), a1 + hstep, voffA);
            PG8_WAIT_L(8); PG8_BAR; PG8_WAIT_L(0); PG8_MMA(0, 0, At, B0); PG8_BAR; PG8_SCHED;
            PG8_LDB(B1, 0, 1); PG8_STAGE(PG8_SB(0, 0), b2, voffB);
            PG8_BAR; PG8_WAIT_L(0); PG8_MMA(0, 1, At, B1); PG8_BAR;
            PG8_LDA(At, 0, 1); PG8_STAGE(PG8_SA(0, 0), a2, voffA);
            PG8_BAR; PG8_WAIT_L(0); PG8_MMA(1, 0, At, B0); PG8_BAR; PG8_SCHED;
            PG8_STAGE(PG8_SB(0, 1), b2 + hstep, voffB);
            PG8_WAIT_V(6); PG8_BAR; PG8_MMA(1, 1, At, B1); PG8_BAR;
            PG8_LDB(B0, 1, 0); PG8_SCHED; PG8_LDA(At, 1, 0); PG8_STAGE(PG8_SA(0, 1), a2 + hstep, voffA);
            PG8_WAIT_L(8); PG8_BAR; PG8_WAIT_L(0); PG8_MMA(0, 0, At, B0); PG8_BAR; PG8_SCHED;
            PG8_LDB(B1, 1, 1); PG8_STAGE(PG8_SB(1, 0), b3, voffB);
            PG8_BAR; PG8_WAIT_L(0); PG8_MMA(0, 1, At, B1); PG8_BAR;
            PG8_LDA(At, 1, 1); PG8_STAGE(PG8_SA(1, 0), a3, voffA);
            PG8_BAR; PG8_WAIT_L(0); PG8_MMA(1, 0, At, B0); PG8_BAR; PG8_SCHED;
            PG8_STAGE(PG8_SB(1, 1), b3 + hstep, voffB);
            PG8_WAIT_V(6); PG8_BAR; PG8_MMA(1, 1, At, B1); PG8_BAR;
            }
        }
        if constexpr (ALIGN_EPI) { if (wr == 0) PG8_BAR; }
        E(acc, cur, wr, wc, fr, fq);
        if (!has_next) break;
#pragma unroll
        for (int a = 0; a < 2; ++a)
#pragma unroll
            for (int b = 0; b < 2; ++b)
#pragma unroll
                for (int m = 0; m < 4; ++m)
#pragma unroll
                    for (int n = 0; n < 2; ++n) acc[a][b][m][n] = (f32x4){0.f, 0.f, 0.f, 0.f};
        cur = nxt; cA = nA; cB = nB; ++ui;
        if constexpr (ALIGN_EPI) { if (wr == 1) PG8_BAR; }
    }
    PG8_WAIT_V(0);
    if constexpr (!ALIGN_EPI) { if (wr == 0) PG8_BAR; }
    PG8_BAR;
#undef PG8_SA
#undef PG8_SB
#undef PG8_STAGE
#undef PG8_LDA
#undef PG8_LDB
#undef PG8_MMA
#undef PG8_WAIT_V
#undef PG8_WAIT_L
#undef PG8_BAR
#undef PG8_SCHED
}

struct UnitX { int pm, pn, seg; };
template <class Prog>
__device__ __forceinline__ void gemm_stream(LAS unsigned char* lds, const Prog& P, int wave_s) {
    const int tid = fresh_tid(wave_s);
    const int wid = __builtin_amdgcn_readfirstlane(tid >> 6), lane = tid & 63, wr = wid >> 2, wc = wid & 3, fr = lane & 15, fq = lane >> 4;
    unsigned r2A[2], r2B[2], c2[2];
#pragma unroll
    for (int i = 0; i < 2; ++i) { int R, C; stage_rc(tid * 16 + i * 8192, R, C); const int Rb = (R & ~31) + perm32(R & 31); r2A[i] = 2u * R; r2B[i] = 2u * Rb; c2[i] = 2u * C; }
    const size_t kstep = (size_t)(BK * 2);
    const unsigned ldsw = (unsigned)wid * 1024u;
    const int aoff = lds_byte(wr * 64 + fr, fq * 8), boff = lds_byte(wc * 32 + fr, fq * 8);
#define GS_SA(b, h) (((b) * 2 + (h)) * HTB)
#define GS_SB(b, h) ((4 + (b) * 2 + (h)) * HTB)
#define GS_STAGE(bufoff, gbase, r2, Kx) do { _Pragma("unroll") for (int _i = 0; _i < 2; ++_i) \
        __builtin_amdgcn_global_load_lds((const unsigned*)((const char*)(gbase) + ((r2)[_i] * (unsigned)(Kx) + c2[_i])), (LAS unsigned*)(lds + (bufoff) + ldsw + _i * 8192), 16, 0, 0); } while (0)
#define GS_LDA(dst, b, h) do { _Pragma("unroll") for (int m = 0; m < 4; ++m) _Pragma("unroll") for (int k = 0; k < 2; ++k) dst[m][k] = *(const LAS bf16x8*)(lds + GS_SA(b, h) + aoff + m * 2048 + k * 1024); } while (0)
#define GS_LDB(dst, b, h) do { _Pragma("unroll") for (int n = 0; n < 2; ++n) _Pragma("unroll") for (int k = 0; k < 2; ++k) dst[n][k] = *(const LAS bf16x8*)(lds + GS_SB(b, h) + boff + n * 2048 + k * 1024); } while (0)
#define GS_MMA(ai, bj, At, Bt) do { __builtin_amdgcn_s_setprio(1); _Pragma("unroll") for (int m = 0; m < 4; ++m) _Pragma("unroll") for (int n = 0; n < 2; ++n) _Pragma("unroll") for (int k = 0; k < 2; ++k) \
        acc[ai][bj][m][n] = __builtin_amdgcn_mfma_f32_16x16x32_bf16(Bt[n][k], At[m][k], acc[ai][bj][m][n], 0, 0, 0); __builtin_amdgcn_s_setprio(0); } while (0)
#define GS_WAIT_V(n) asm volatile("s_waitcnt vmcnt(" #n ")" ::: "memory")
#define GS_WAIT_L(n) asm volatile("s_waitcnt lgkmcnt(" #n ")" ::: "memory")
#define GS_BAR __builtin_amdgcn_s_barrier()
#define GS_SCHED __builtin_amdgcn_sched_barrier(0)
    UnitX cur, nxt; int ui = 0;
    if (!P.next(0, cur)) return;
    f32x4 acc[2][2][4][2];
#pragma unroll
    for (int a = 0; a < 2; ++a)
#pragma unroll
        for (int b = 0; b < 2; ++b)
#pragma unroll
            for (int m = 0; m < 4; ++m)
#pragma unroll
                for (int n = 0; n < 2; ++n) acc[a][b][m][n] = (f32x4){0.f, 0.f, 0.f, 0.f};
    bf16x8 At[4][2], B0[2][2], B1[2][2];
    const bf16_t* gA; const bf16_t* gB; int Kc;
    P.desc(cur.seg, gA, gB, Kc);
    size_t hc = (size_t)HALF * Kc * 2;
    const char* cA = (const char*)gA + (size_t)cur.pm * 2 * hc; const char* cB = (const char*)gB + (size_t)cur.pn * 2 * hc;
    GS_STAGE(GS_SB(0, 0), cB, r2B, Kc); GS_STAGE(GS_SB(0, 1), cB + hc, r2B, Kc); GS_STAGE(GS_SA(0, 0), cA, r2A, Kc); GS_STAGE(GS_SA(0, 1), cA + hc, r2A, Kc);
    if (wr == 1) GS_BAR;
    GS_WAIT_V(2); GS_BAR;
    GS_STAGE(GS_SB(1, 0), cB + kstep, r2B, Kc); GS_STAGE(GS_SA(1, 0), cA + kstep, r2A, Kc); GS_STAGE(GS_SB(1, 1), cB + hc + kstep, r2B, Kc);
    GS_WAIT_V(6); GS_BAR;
    for (;;) {
        const bool has_next = P.next(ui + 1, nxt);
        const bf16_t* nAg = gA; const bf16_t* nBg = gB; int Kn = Kc;
        if (has_next) P.desc(nxt.seg, nAg, nBg, Kn);
        const size_t hn = (size_t)HALF * Kn * 2;
        const char* nA = has_next ? (const char*)nAg + (size_t)nxt.pm * 2 * hn : cA; const char* nB = has_next ? (const char*)nBg + (size_t)nxt.pn * 2 * hn : cB;
        const int nt = Kc / BK;
        for (int t = 0; t < nt; t += 2) {
            const bool last = (t == nt - 2);
            const char* a1 = cA + (size_t)(t + 1) * kstep;
            const char* a2 = last ? nA : cA + (size_t)(t + 2) * kstep; const char* b2 = last ? nB : cB + (size_t)(t + 2) * kstep;
            const char* a3 = a2 + kstep; const char* b3 = b2 + kstep;
            int K2 = last ? Kn : Kc; size_t h2 = last ? hn : hc;
            asm volatile("" : "+s"(a1), "+s"(a2), "+s"(b2), "+s"(a3), "+s"(b3));
            GS_LDB(B0, 0, 0); GS_LDB(B1, 0, 1); GS_SCHED; GS_LDA(At, 0, 0); GS_STAGE(GS_SA(1, 1), a1 + hc, r2A, Kc);
            GS_WAIT_V(8); GS_WAIT_L(0); GS_BAR; GS_MMA(0, 0, At, B0); GS_MMA(0, 1, At, B1); GS_BAR; GS_SCHED;
            GS_LDA(At, 0, 1); GS_STAGE(GS_SB(0, 0), b2, r2B, K2); GS_STAGE(GS_SB(0, 1), b2 + h2, r2B, K2); GS_STAGE(GS_SA(0, 0), a2, r2A, K2);
            GS_WAIT_V(8); GS_WAIT_L(0); GS_BAR; GS_MMA(1, 0, At, B0); GS_MMA(1, 1, At, B1); GS_BAR; GS_SCHED;
            GS_LDB(B0, 1, 0); GS_LDB(B1, 1, 1); GS_SCHED; GS_LDA(At, 1, 0); GS_STAGE(GS_SA(0, 1), a2 + h2, r2A, K2);
            GS_WAIT_V(8); GS_WAIT_L(0); GS_BAR; GS_MMA(0, 0, At, B0); GS_MMA(0, 1, At, B1); GS_BAR; GS_SCHED;
            GS_LDA(At, 1, 1); GS_STAGE(GS_SB(1, 0), b3, r2B, K2); GS_STAGE(GS_SB(1, 1), b3 + h2, r2B, K2); GS_STAGE(GS_SA(1, 0), a3, r2A, K2);
            GS_WAIT_V(8); GS_WAIT_L(0); GS_BAR; GS_MMA(1, 0, At, B0); GS_MMA(1, 1, At, B1); GS_BAR; GS_SCHED;
        }
        if (wr == 0) GS_BAR;
        P.epi(cur.seg, acc, cur, wr, wc, fr, fq);
        if (!has_next) break;
#pragma unroll
        for (int a = 0; a < 2; ++a)
#pragma unroll
            for (int b = 0; b < 2; ++b)
#pragma unroll
                for (int m = 0; m < 4; ++m)
#pragma unroll
                    for (int n = 0; n < 2; ++n) acc[a][b][m][n] = (f32x4){0.f, 0.f, 0.f, 0.f};
        cur = nxt; cA = nA; cB = nB; gA = nAg; gB = nBg; Kc = Kn; hc = hn; ++ui;
        if (wr == 1) GS_BAR;
    }
    GS_WAIT_V(0);
    GS_BAR;
#undef GS_SA
#undef GS_SB
#undef GS_STAGE
#undef GS_LDA
#undef GS_LDB
#undef GS_MMA
#undef GS_WAIT_V
#undef GS_WAIT_L
#undef GS_BAR
#undef GS_SCHED
}
}
using pg8::Unit;
typedef f32x4 Acc[2][2][4][2];

#define EPI_ROWS_BEGIN  _Pragma("unroll") for (int ai = 0; ai < 2; ++ai) _Pragma("unroll") for (int m = 0; m < 4; ++m) { const size_t row = (size_t)(row0 + ai * 128 + m * 16);
#define EPI_ROWS_END    if (m & 1) asm volatile("" ::: "memory"); }

struct EpiSwiglu { static constexpr bool PERM = true;
    bf16_t* H; const float* ssq;
    __device__ __forceinline__ void operator()(const Acc& acc, const Unit& u, int wr, int wc, int fr, int fq) const {
        { const int t_ = fresh_lane(); fr = t_ & 15; fq = (t_ >> 4) & 3; }
        const int row0 = u.pm * 256 + wr * 64 + fr, col0 = u.pn * 128 + wc * 32 + 8 * fq;
        float rs8[8]; rstd8<16>(rs8, ssq, row0, fq, 1.0f / 1024.0f);
        EPI_ROWS_BEGIN
            const float rstd = rs8[ai * 4 + m];
            f32x4 hv[2];
#pragma unroll
            for (int n = 0; n < 2; ++n) { const f32x4 g = acc[ai][0][m][n] * rstd, up = acc[ai][1][m][n] * rstd;
#pragma unroll
                for (int e = 0; e < 4; ++e) { const float sg = __builtin_amdgcn_rcpf(1.0f + __builtin_amdgcn_exp2f(-1.4426950408889634f * g[e])); hv[n][e] = g[e] * sg * up[e]; } }
            *(u32x4*)(H + row * DFF + col0) = pack8(hv[0], hv[1]);
        EPI_ROWS_END
    }
};
struct EpiResid { static constexpr bool PERM = true;
    bf16_t* XB; float* SSQ; float scale;
    __device__ __forceinline__ void operator()(const Acc& acc, const Unit& u, int wr, int wc, int fr, int fq) const {
        { const int t_ = fresh_lane(); fr = t_ & 15; fq = (t_ >> 4) & 3; }
        const int row0 = u.pm * 256 + wr * 64 + fr, col0 = u.pn * 256 + wc * 32 + 8 * fq;
        EPI_ROWS_BEGIN
            float s = 0.f;
#pragma unroll
            for (int bj = 0; bj < 2; ++bj) { bf16_t* xp = XB + row * DM + col0 + bj * 128;
                const u32x4 w = *(const u32x4*)xp;
                f32x4 x0 = {bf2f(w.x & 0xffffu), bf2f(w.x >> 16), bf2f(w.y & 0xffffu), bf2f(w.y >> 16)}, x1 = {bf2f(w.z & 0xffffu), bf2f(w.z >> 16), bf2f(w.w & 0xffffu), bf2f(w.w >> 16)};
                x0 += acc[ai][bj][m][0] * scale; x1 += acc[ai][bj][m][1] * scale;
                *(u32x4*)xp = pack8(x0, x1);
                s += dot4(x0) + dot4(x1); }
            s += __shfl_xor(s, 16); s += __shfl_xor(s, 32);
            if (fq == 0) SSQ[row * 16 + u.pn * 4 + wc] = s;
        EPI_ROWS_END
    }
};
struct EpiIn { static constexpr bool PERM = true;
    const float* ssqx; bf16_t* XPOOL; bf16_t* KVLAT; bf16_t* QLAT; bf16_t* KROPE; float* SSQQ; float* SSQKV; const float* CS;
    __device__ __forceinline__ void operator()(const Acc& acc, const Unit& u, int wr, int wc, int fr, int fq) const {
        { const int t_ = fresh_lane(); fr = t_ & 15; fq = (t_ >> 4) & 3; }
        const int row0 = u.pm * 256 + wr * 64 + fr, lc = wc * 32 + 8 * fq, pn = u.pn;
        float rs8[8]; rstd8<16>(rs8, ssqx, row0, fq, 1.0f / 1024.0f);
        if (pn < 2) {
            EPI_ROWS_BEGIN
                const float rstd = rs8[ai * 4 + m];
#pragma unroll
                for (int bj = 0; bj < 2; ++bj) *(u32x4*)(XPOOL + row * 512 + pn * 256 + bj * 128 + lc) = pack8(acc[ai][bj][m][0] * rstd, acc[ai][bj][m][1] * rstd);
            EPI_ROWS_END
        } else if (pn < 4) {
            bf16_t* dst = (pn == 2) ? KVLAT : QLAT; const int ld = (pn == 2) ? 256 : 384; float* sq = (pn == 2) ? SSQKV : SSQQ; const int sld = (pn == 2) ? 4 : 8;
            EPI_ROWS_BEGIN
                const float rstd = rs8[ai * 4 + m];
                float s = 0.f;
#pragma unroll
                for (int bj = 0; bj < 2; ++bj) { const f32x4 v0 = acc[ai][bj][m][0] * rstd, v1 = acc[ai][bj][m][1] * rstd;
                    *(u32x4*)(dst + row * ld + bj * 128 + lc) = pack8(v0, v1); s += dot4(v0) + dot4(v1); }
                s += __shfl_xor(s, 16); s += __shfl_xor(s, 32);
                if (fq == 0) sq[row * sld + wc] = s;
            EPI_ROWS_END
        } else {
            EPI_ROWS_BEGIN
                const float rstd = rs8[ai * 4 + m];
                const f32x4 v0 = acc[ai][0][m][0] * rstd, v1 = acc[ai][0][m][1] * rstd;
                *(u32x4*)(QLAT + row * 384 + 256 + lc) = pack8(v0, v1);
                float s = dot4(v0) + dot4(v1);
                s += __shfl_xor(s, 16); s += __shfl_xor(s, 32);
                if (fq == 0) SSQQ[row * 8 + 4 + wc] = s;
                if (wc < 2) {
                    const int i0 = 16 * wc + 4 * fq;
                    const f32x4 c01 = *(const f32x4*)(CS + (row * 32 + i0) * 2), c23 = *(const f32x4*)(CS + (row * 32 + i0) * 2 + 4);
                    const f32x4 cs = {c01[0], c01[2], c23[0], c23[2]}, sn = {c01[1], c01[3], c23[1], c23[3]};
                    const f32x4 x1 = acc[ai][1][m][0] * rstd, x2 = acc[ai][1][m][1] * rstd;
                    const f32x4 o1 = x1 * cs - x2 * sn, o2 = x2 * cs + x1 * sn;
                    u32x2 w1, w2; w1.x = pk2(o1[0], o1[1]); w1.y = pk2(o1[2], o1[3]); w2.x = pk2(o2[0], o2[1]); w2.y = pk2(o2[2], o2[3]);
                    *(u32x2*)(KROPE + row * 64 + i0) = w1; *(u32x2*)(KROPE + row * 64 + 32 + i0) = w2;
                }
            EPI_ROWS_END
        }
    }
};
struct EpiGate { static constexpr bool PERM = true;
    const float* ssqx; const float* bias; bf16_t* G;
    __device__ __forceinline__ void operator()(const Acc& acc, const Unit& u, int wr, int wc, int fr, int fq) const {
        { const int t_ = fresh_lane(); fr = t_ & 15; fq = (t_ >> 4) & 3; }
        const int row0 = u.pm * 256 + wr * 64 + fr, col0 = u.pn * 256 + wc * 32 + 8 * fq;
        f32x4 bv[2][2];
#pragma unroll
        for (int bj = 0; bj < 2; ++bj)
#pragma unroll
            for (int n = 0; n < 2; ++n) bv[bj][n] = *(const f32x4*)(bias + col0 + bj * 128 + 4 * n);
        float rs8[8]; rstd8<16>(rs8, ssqx, row0, fq, 1.0f / 1024.0f);
        EPI_ROWS_BEGIN
            const float rstd = rs8[ai * 4 + m];
#pragma unroll
            for (int bj = 0; bj < 2; ++bj) { f32x4 gv[2];
#pragma unroll
                for (int n = 0; n < 2; ++n) { const f32x4 z = acc[ai][bj][m][n] * rstd + bv[bj][n];
#pragma unroll
                    for (int e = 0; e < 4; ++e) gv[n][e] = __builtin_rintf(255.0f * __builtin_amdgcn_rcpf(1.0f + __builtin_amdgcn_exp2f(-1.4426950408889634f * z[e]))); }
                u32x2 w; w.x = 0u; w.y = 0u;
#pragma unroll
                for (int e = 0; e < 4; ++e) { w.x = __builtin_amdgcn_cvt_pk_u8_f32(gv[0][e], e, w.x); w.y = __builtin_amdgcn_cvt_pk_u8_f32(gv[1][e], e, w.y); }
                *(u32x2*)((unsigned char*)G + row * DM + col0 + bj * 128) = w; }
        EPI_ROWS_END
    }
};
template <int MODE> struct EpiGated { static constexpr bool PERM = true;
    const bf16_t* G; bf16_t* MB;
    __device__ __forceinline__ void operator()(const Acc& acc, const Unit& u, int wr, int wc, int fr, int fq) const {
        { const int t_ = fresh_lane(); fr = t_ & 15; fq = (t_ >> 4) & 3; }
        const int row0 = u.pm * 256 + wr * 64 + fr, col0 = u.pn * 256 + wc * 32 + 8 * fq;
        EPI_ROWS_BEGIN
#pragma unroll
            for (int bj = 0; bj < 2; ++bj) { const size_t off = row * DM + col0 + bj * 128;
                const u32x2 gw = *(const u32x2*)((const unsigned char*)G + off);
                const float k255 = 1.0f / 255.0f;
                f32x4 g0 = {(float)(gw.x & 0xffu) * k255, (float)((gw.x >> 8) & 0xffu) * k255, (float)((gw.x >> 16) & 0xffu) * k255, (float)(gw.x >> 24) * k255};
                f32x4 g1 = {(float)(gw.y & 0xffu) * k255, (float)((gw.y >> 8) & 0xffu) * k255, (float)((gw.y >> 16) & 0xffu) * k255, (float)(gw.y >> 24) * k255};
                f32x4 r0 = g0 * acc[ai][bj][m][0], r1 = g1 * acc[ai][bj][m][1];
                if (MODE == 1) { const u32x4 mw = *(const u32x4*)(MB + off);
                    r0 += (f32x4){bf2f(mw.x & 0xffffu), bf2f(mw.x >> 16), bf2f(mw.y & 0xffffu), bf2f(mw.y >> 16)}; r1 += (f32x4){bf2f(mw.z & 0xffffu), bf2f(mw.z >> 16), bf2f(mw.w & 0xffffu), bf2f(mw.w >> 16)}; }
                *(u32x4*)(MB + off) = pack8(r0, r1); }
        EPI_ROWS_END
    }
};
struct EpiPlain { static constexpr bool PERM = true;
    bf16_t* O; int ldc;
    __device__ __forceinline__ void operator()(const Acc& acc, const Unit& u, int wr, int wc, int fr, int fq) const {
        { const int t_ = fresh_lane(); fr = t_ & 15; fq = (t_ >> 4) & 3; }
        const int row0 = u.pm * 256 + wr * 64 + fr, col0 = u.pn * 256 + wc * 32 + 8 * fq;
        EPI_ROWS_BEGIN
#pragma unroll
            for (int bj = 0; bj < 2; ++bj) *(u32x4*)(O + row * ldc + col0 + bj * 128) = pack8(acc[ai][bj][m][0], acc[ai][bj][m][1]);
        EPI_ROWS_END
    }
};
struct EpiQ { static constexpr bool PERM = true;
    const float* ssqq; const float* CS; bf16_t* QB;
    __device__ __forceinline__ void operator()(const Acc& acc, const Unit& u, int wr, int wc, int fr, int fq) const {
        { const int t_ = fresh_lane(); fr = t_ & 15; fq = (t_ >> 4) & 3; }
        const int row0 = u.pm * 256 + wr * 64 + fr, pn = u.pn;
        float rs8[8]; rstd8<8>(rs8, ssqq, row0, fq, 1.0f / 384.0f);
        if (pn < 4) {
            EPI_ROWS_BEGIN
                const float rs = rs8[ai * 4 + m] * QSCALE;
                bf16_t* qp = QB + row * 1536 + (2 * pn) * 192 + wc * 32 + 8 * fq;
                *(u32x4*)qp = pack8(acc[ai][0][m][0] * rs, acc[ai][0][m][1] * rs);
                *(u32x4*)(qp + 192) = pack8(acc[ai][1][m][0] * rs, acc[ai][1][m][1] * rs);
            EPI_ROWS_END
        } else {
            const int i0 = 16 * (wc & 1) + 4 * fq, head0 = 4 * (pn - 4) + (wc >> 1);
            EPI_ROWS_BEGIN
                const float rs = rs8[ai * 4 + m] * QSCALE;
                const f32x4 c01 = *(const f32x4*)(CS + (row * 32 + i0) * 2), c23 = *(const f32x4*)(CS + (row * 32 + i0) * 2 + 4);
                const f32x4 cs = {c01[0] * rs, c01[2] * rs, c23[0] * rs, c23[2] * rs}, sn = {c01[1] * rs, c01[3] * rs, c23[1] * rs, c23[3] * rs};
                bf16_t* qp = QB + row * 1536 + head0 * 192 + 128 + i0;
#pragma unroll
                for (int bj = 0; bj < 2; ++bj) {
                    const f32x4 x1 = acc[ai][bj][m][0], x2 = acc[ai][bj][m][1];
                    const f32x4 o1 = x1 * cs - x2 * sn, o2 = x2 * cs + x1 * sn;
                    u32x2 w1, w2; w1.x = pk2(o1[0], o1[1]); w1.y = pk2(o1[2], o1[3]); w2.x = pk2(o2[0], o2[1]); w2.y = pk2(o2[2], o2[3]);
                    *(u32x2*)(qp + bj * 384) = w1; *(u32x2*)(qp + bj * 384 + 32) = w2; }
            EPI_ROWS_END
        }
    }
};
struct EpiKV { static constexpr bool PERM = true;
    const float* ssqkv; bf16_t* KN; bf16_t* VT; LAS unsigned char* scr;
    __device__ __forceinline__ void operator()(const Acc& acc, const Unit& u, int wr, int wc, int fr, int fq) const {
        const int lane = fresh_lane(); fr = lane & 15; fq = (lane >> 4) & 3;
        const int row0 = u.pm * 256 + wr * 64 + fr, lc = wc * 32 + 8 * fq, pn = u.pn;
        const int pfr = (fr & 3) | ((fr & 4) << 1) | ((fr & 8) >> 1);
        float rs8[8]; rstd8<4>(rs8, ssqkv, row0, fq, 1.0f / 256.0f);
        EPI_ROWS_BEGIN
            const float rs = rs8[ai * 4 + m];
            *(u32x4*)(KN + row * 1024 + pn * 128 + lc) = pack8(acc[ai][0][m][0] * rs, acc[ai][0][m][1] * rs);
        EPI_ROWS_END
        LAS unsigned char* my = scr + (wr * 4 + wc) * 2816;
        const int rrow = lane >> 2, rc2 = lane & 3;
#pragma unroll
        for (int ai = 0; ai < 2; ++ai) {
            const int rbase = u.pm * 256 + ai * 128 + wr * 64, b = rbase >> 11, s0 = rbase & 2047;
#pragma unroll
            for (int n = 0; n < 2; ++n) {
#pragma unroll
                for (int m = 0; m < 4; ++m) { const float rs = rs8[ai * 4 + m];
#pragma unroll
                    for (int e = 0; e < 4; ++e) *(LAS bf16_t*)(my + (4 * fq + e) * 176 + (16 * m + pfr) * 2) = (bf16_t)(pk2(acc[ai][1][m][n][e] * rs, 0.f) & 0xffffu); }
                asm volatile("s_waitcnt lgkmcnt(0)" ::: "memory");
                const u32x4 v0 = *(const LAS u32x4*)(my + rrow * 176 + rc2 * 32), v1 = *(const LAS u32x4*)(my + rrow * 176 + rc2 * 32 + 16);
                const int d = 32 * wc + 8 * (rrow >> 2) + 4 * n + (rrow & 3);
                bf16_t* vp = VT + ((size_t)(b * 8 + pn) * 128 + d) * 2048 + s0 + rc2 * 16;
                *(u32x4*)vp = v0; *(u32x4*)(vp + 8) = v1;
                asm volatile("s_waitcnt lgkmcnt(0)" ::: "memory");
            }
        }
    }
};


struct ProgMerge {
    pg8::StaticOrder S; int n;
    const bf16_t* XB; const bf16_t* MIXED; const bf16_t* AO; const bf16_t* Wg; const bf16_t* Wpp; const bf16_t* Wap;
    EpiGate EA, EB; EpiGated<0> E0; EpiGated<1> E1;
    __device__ __forceinline__ bool next(int i, pg8::UnitX& u) const {
        int seg = 0, j = i; while (j >= n && seg < 4) { j -= n; ++seg; }
        if (seg >= 4 || n <= 0) return false;
        Unit uu; if (!S.next(j, uu)) return false;
        u.pm = uu.pm; u.pn = uu.pn; u.seg = seg; return true;
    }
    __device__ __forceinline__ void desc(int seg, const bf16_t*& A, const bf16_t*& Bt, int& K) const {
        if (seg == 0) { A = XB; Bt = Wg; K = 1024; }
        else if (seg == 1) { A = MIXED; Bt = Wpp; K = 512; }
        else if (seg == 2) { A = XB; Bt = Wg + (size_t)1024 * 1024; K = 1024; }
        else { A = AO; Bt = Wap; K = 1024; }
    }
    __device__ __forceinline__ void epi(int seg, const Acc& acc, const pg8::UnitX& ux, int wr, int wc, int fr, int fq) const {
        const Unit u{ux.pm, ux.pn};
        if (seg == 0) EA(acc, u, wr, wc, fr, fq);
        else if (seg == 1) E0(acc, u, wr, wc, fr, fq);
        else if (seg == 2) EB(acc, u, wr, wc, fr, fq);
        else E1(acc, u, wr, wc, fr, fq);
    }
};

namespace att {
constexpr int KROW = 400, VROW = 144;
constexpr int KBUF = 64 * KROW, VBUF = 128 * VROW;
constexpr int OFF_K = 0, OFF_V = 2 * KBUF, LDS_BYTES = 2 * KBUF + 2 * VBUF;
__device__ __forceinline__ int crow(int r, int hi) { return (r & 3) + 8 * (r >> 2) + 4 * hi; }
#define MFMA32(a, b, c) __builtin_amdgcn_mfma_f32_32x32x16_bf16((a), (b), (c), 0, 0, 0)

__device__ __forceinline__ void attn_unit(LAS unsigned char* L, int b, int h, int qb, const bf16_t* QB, const bf16_t* KN, const bf16_t* KR, const bf16_t* VT, bf16_t* AO, int wave_s) {
    const int tid = fresh_tid(wave_s);
    const int lane = tid & 63, wid = __builtin_amdgcn_readfirstlane(tid >> 6), q = lane & 31, hi = lane >> 5;
    const int rowbase = b * SEQ, q0 = qb * 256, myq0 = q0 + 32 * wid, NT = (q0 + 256) >> 6;
    const int kr0 = tid >> 4, kc0 = tid & 15;
    const int rr = tid >> 3, rc = tid & 7;
    const bf16_t* kn_src = KN + (size_t)(rowbase + kr0) * 1024 + h * 128 + kc0 * 8;
    const bf16_t* kr_src = KR + (size_t)(rowbase + rr) * 64 + rc * 8;
    const bf16_t* vt_src = VT + ((size_t)(b * 8 + h) * 128 + rr) * 2048 + rc * 8;
    const int kn_dst = kr0 * KROW + kc0 * 16, kr_dst = rr * KROW + 256 + rc * 16, vt_dst = rr * VROW + rc * 16;
    u32x4 sk0, sk1, sk2, sv0, sv1;
#define ATT_LOAD_K(kt) do { sk0 = *(const u32x4*)(kn_src + (size_t)(kt) * 64 * 1024); sk1 = *(const u32x4*)(kn_src + (size_t)(kt) * 64 * 1024 + 32 * 1024); \
        sk2 = *(const u32x4*)(kr_src + (size_t)(kt) * 64 * 64); } while (0)
#define ATT_LOAD_V(kt) do { sv0 = *(const u32x4*)(vt_src + (kt) * 64); sv1 = *(const u32x4*)(vt_src + (size_t)64 * 2048 + (kt) * 64); } while (0)
#define ATT_STORE_K(buf) do { LAS unsigned char* kb_ = L + OFF_K + (buf) * KBUF; \
        *(LAS u32x4*)(kb_ + kn_dst) = sk0; *(LAS u32x4*)(kb_ + kn_dst + 32 * KROW) = sk1; *(LAS u32x4*)(kb_ + kr_dst) = sk2; } while (0)
#define ATT_STORE_V(buf) do { LAS unsigned char* vb_ = L + OFF_V + (buf) * VBUF; \
        *(LAS u32x4*)(vb_ + vt_dst) = sv0; *(LAS u32x4*)(vb_ + vt_dst + 64 * VROW) = sv1; } while (0)
    ATT_LOAD_K(0); ATT_LOAD_V(0);
    bf16x8 qf[12];
    { const bf16_t* qp = QB + (size_t)(rowbase + myq0 + q) * 1536 + h * 192 + 8 * hi;
#pragma unroll
      for (int d0 = 0; d0 < 12; ++d0) qf[d0] = *(const bf16x8*)(qp + 16 * d0); }
    f32x16 o[4];
#pragma unroll
    for (int dt = 0; dt < 4; ++dt)
#pragma unroll
        for (int r = 0; r < 16; ++r) o[dt][r] = 0.f;
    float mrun = -1e30f, lrun = 0.f;
    ATT_STORE_K(0); ATT_STORE_V(0);
    ATT_LOAD_K(1);
    __syncthreads();
#define END_EVEN(kt) do { if ((kt) + 1 < NT) { ATT_STORE_K(((kt) + 1) & 1); ATT_LOAD_V((kt) + 1); } } while (0)
#define END_ODD(kt)  do { if ((kt) + 1 < NT) ATT_STORE_V(((kt) + 1) & 1); if ((kt) + 2 < NT) ATT_LOAD_K((kt) + 2); } while (0)
#define SB_() __builtin_amdgcn_sched_barrier(0)
#define X_BODY(kt) \
    f32x16 p0, p1; \
    { const LAS unsigned char* kb = L + OFF_K + ((kt) & 1) * KBUF + q * KROW + hi * 16; \
      _Pragma("unroll") for (int r = 0; r < 16; ++r) { p0[r] = 0.f; p1[r] = 0.f; } \
      bf16x8 ka[3][2]; \
      ka[0][0] = *(const LAS bf16x8*)(kb); ka[0][1] = *(const LAS bf16x8*)(kb + 32 * KROW); \
      ka[1][0] = *(const LAS bf16x8*)(kb + 32); ka[1][1] = *(const LAS bf16x8*)(kb + 32 * KROW + 32); \
      ka[2][0] = *(const LAS bf16x8*)(kb + 64); ka[2][1] = *(const LAS bf16x8*)(kb + 32 * KROW + 64); \
      SB_(); \
      _Pragma("unroll") for (int d0 = 0; d0 < 12; ++d0) { \
          p0 = MFMA32(ka[d0 % 3][0], qf[d0], p0); p1 = MFMA32(ka[d0 % 3][1], qf[d0], p1); \
          SB_(); \
          if (d0 + 3 < 12) { ka[d0 % 3][0] = *(const LAS bf16x8*)(kb + (d0 + 3) * 32); ka[d0 % 3][1] = *(const LAS bf16x8*)(kb + 32 * KROW + (d0 + 3) * 32); SB_(); } } \
      if ((kt) * 64 + 63 > myq0) { const int qi = myq0 + q, kbase = (kt) * 64; \
          _Pragma("unroll") for (int r = 0; r < 16; ++r) { const int key = kbase + crow(r, hi); if (key > qi) p0[r] = -1e30f; if (key + 32 > qi) p1[r] = -1e30f; } } \
      float mx = p0[0]; \
      _Pragma("unroll") for (int r = 1; r < 16; ++r) mx = fmaxf(mx, p0[r]); \
      _Pragma("unroll") for (int r = 0; r < 16; ++r) mx = fmaxf(mx, p1[r]); \
      { const auto rr_ = __builtin_amdgcn_permlane32_swap(__float_as_uint(mx), __float_as_uint(mx), false, false);        \
        mx = fmaxf(__uint_as_float(rr_[0]), __uint_as_float(rr_[1])); } \
      if (__any(mx > mrun + 8.0f)) { const float mnew = fmaxf(mrun, mx), alpha = __builtin_amdgcn_exp2f(mrun - mnew); \
          lrun *= alpha; \
          _Pragma("unroll") for (int dt = 0; dt < 4; ++dt) _Pragma("unroll") for (int r = 0; r < 16; ++r) o[dt][r] *= alpha; \
          mrun = mnew; } }
#define Y_BODY(kt) \
    { const LAS unsigned char* vb = L + OFF_V + ((kt) & 1) * VBUF + q * VROW + hi * 16; \
      bf16x8 va[4]; \
      _Pragma("unroll") for (int i_ = 0; i_ < 4; ++i_) va[i_] = *(const LAS bf16x8*)(vb + i_ * 32 * VROW); \
      SB_(); \
      float ls = 0.f; \
      _Pragma("unroll") for (int r = 0; r < 16; ++r) { p0[r] = __builtin_amdgcn_exp2f(p0[r] - mrun); p1[r] = __builtin_amdgcn_exp2f(p1[r] - mrun); ls += p0[r] + p1[r]; } \
      lrun += ls; \
      bf16x8 pf[4]; \
      { u32x4 w; \
        w.x = pk2(p0[0], p0[1]); w.y = pk2(p0[2], p0[3]); w.z = pk2(p0[4], p0[5]); w.w = pk2(p0[6], p0[7]); pf[0] = __builtin_bit_cast(bf16x8, w); \
        w.x = pk2(p0[8], p0[9]); w.y = pk2(p0[10], p0[11]); w.z = pk2(p0[12], p0[13]); w.w = pk2(p0[14], p0[15]); pf[1] = __builtin_bit_cast(bf16x8, w); \
        w.x = pk2(p1[0], p1[1]); w.y = pk2(p1[2], p1[3]); w.z = pk2(p1[4], p1[5]); w.w = pk2(p1[6], p1[7]); pf[2] = __builtin_bit_cast(bf16x8, w); \
        w.x = pk2(p1[8], p1[9]); w.y = pk2(p1[10], p1[11]); w.z = pk2(p1[12], p1[13]); w.w = pk2(p1[14], p1[15]); pf[3] = __builtin_bit_cast(bf16x8, w); } \
      SB_(); \
      _Pragma("unroll") for (int i_ = 0; i_ < 16; ++i_) {            \
          o[i_ & 3] = MFMA32(va[i_ & 3], pf[i_ >> 2], o[i_ & 3]); \
          SB_(); \
          if (i_ + 4 < 16) { va[i_ & 3] = *(const LAS bf16x8*)(vb + ((i_ + 4) & 3) * 32 * VROW + ((i_ + 4) >> 2) * 32); SB_(); } } }
    if (wid >= 4) __builtin_amdgcn_s_setprio(1);
    const int grp = wid >> 2, ktmax = (myq0 + 31) >> 6, nact = (ktmax + 1 < NT) ? ktmax + 1 : NT;
    if (grp == 0) {
        int kt = 0;
        for (; kt < nact; ++kt) {
            X_BODY(kt) END_EVEN(kt); __syncthreads();
            Y_BODY(kt) END_ODD(kt); __syncthreads();
        }
        for (; kt < NT; ++kt) { END_EVEN(kt); __syncthreads(); END_ODD(kt); __syncthreads(); }
        __syncthreads();
    } else {
        END_EVEN(0); __syncthreads();
        int kt = 0;
        for (; kt < nact; ++kt) {
            X_BODY(kt) END_ODD(kt); __syncthreads();
            Y_BODY(kt) END_EVEN(kt + 1); __syncthreads();
        }
        for (; kt < NT; ++kt) { END_ODD(kt); __syncthreads(); END_EVEN(kt + 1); __syncthreads(); }
    }
#undef END_EVEN
#undef END_ODD
#undef X_BODY
#undef SB_
#undef Y_BODY
    __builtin_amdgcn_s_setprio(0);
    float lt;
    { const auto rr_ = __builtin_amdgcn_permlane32_swap(__float_as_uint(lrun), __float_as_uint(lrun), false, false); lt = __uint_as_float(rr_[0]) + __uint_as_float(rr_[1]); }
    const float inv = 1.0f / lt;
    bf16_t* op = AO + (size_t)(rowbase + myq0 + q) * 1024 + h * 128 + 8 * hi;
#pragma unroll
    for (int dt = 0; dt < 4; ++dt)
#pragma unroll
        for (int p = 0; p < 2; ++p) {
            unsigned ax = pk2(o[dt][8 * p] * inv, o[dt][8 * p + 1] * inv), ay = pk2(o[dt][8 * p + 2] * inv, o[dt][8 * p + 3] * inv);
            unsigned bx_ = pk2(o[dt][8 * p + 4] * inv, o[dt][8 * p + 5] * inv), by_ = pk2(o[dt][8 * p + 6] * inv, o[dt][8 * p + 7] * inv);
            { auto r = __builtin_amdgcn_permlane32_swap(ax, bx_, false, false); ax = r[0]; bx_ = r[1]; }
            { auto r = __builtin_amdgcn_permlane32_swap(ay, by_, false, false); ay = r[0]; by_ = r[1]; }
            u32x4 w; w.x = ax; w.y = ay; w.z = bx_; w.w = by_;
            *(u32x4*)(op + 32 * dt + 16 * p) = w; }
#undef ATT_LOAD_K
#undef ATT_LOAD_V
#undef ATT_STORE_K
#undef ATT_STORE_V
}
}

struct Params {
    const float* x; const int* pos; const float* norm_ffn1; const float* ffn1_up; const float* ffn1_down; const float* norm_mix; const float* w_in; const float* b_gate;
    const float* pool_maps; const float* pool_scale; const float* w_pool_proj; const float* q_latent_norm; const float* w_uq; const float* kv_latent_norm; const float* w_ukv;
    const float* w_attn_proj; const float* w_out; const float* norm_ffn2; const float* ffn2_up; const float* ffn2_down; const float* final_norm;
    float* out; unsigned char* ws; int ph_lo, ph_hi;
};
constexpr int NPH_LAYER = 10, NPH = DEPTH * NPH_LAYER + 1;
constexpr int LDS_EXTRA = 131072 + 256;
constexpr int LDS_BYTES = LDS_EXTRA + 8 * 2816;

__device__ const float INVF[32] = {1.000000000e+00f, 7.498942093e-01f, 5.623413252e-01f, 4.216965034e-01f, 3.162277660e-01f, 2.371373706e-01f, 1.778279410e-01f, 1.333521432e-01f,
    1.000000000e-01f, 7.498942093e-02f, 5.623413252e-02f, 4.216965034e-02f, 3.162277660e-02f, 2.371373706e-02f, 1.778279410e-02f, 1.333521432e-02f,
    1.000000000e-02f, 7.498942093e-03f, 5.623413252e-03f, 4.216965034e-03f, 3.162277660e-03f, 2.371373706e-03f, 1.778279410e-03f, 1.333521432e-03f,
    1.000000000e-03f, 7.498942093e-04f, 5.623413252e-04f, 4.216965034e-04f, 3.162277660e-04f, 2.371373706e-04f, 1.778279410e-04f, 1.333521432e-04f};

__device__ __forceinline__ float wave_sum(float v) {
#pragma unroll
    for (int o = 1; o < 64; o <<= 1) v += __shfl_xor(v, o);
    return v;
}
#define LDS_WAIT() asm volatile("s_waitcnt lgkmcnt(0)" ::: "memory")

template <int MAP> __device__ __forceinline__ void conv_mat(const float* src, int ld, int K, int Np, int col0, bf16_t* dst, const float* rscale, const float* aux, LAS float* scr, int gw, int NGW, int lane, int& rot) {
    const int nblk = Np / 32, nitems = (K / 64) * nblk;
    int it0 = gw - rot; if (it0 < 0) it0 += NGW;
    rot = (rot + nitems) % NGW;
    for (int it = it0; it < nitems; it += NGW) {
        const int kb = it / nblk, nb = it % nblk, k0 = 64 * kb, n0 = 32 * nb, n4 = lane & 7, kq = lane >> 3, np = n0 + 4 * n4;
        int col = np + col0, kbase = k0, sld = ld; bool valid = true; float cs = 1.f; const float* sp = src;
        if (MAP == 1) { const int t = np >> 8, half = (np >> 7) & 1, j = np & 127; col = half * DFF + t * 128 + j; }
        if (MAP == 2) {
            if (np < 512) col = np;
            else if (np < 768) col = 896 + (np - 512);
            else if (np < 1152) col = 512 + (np - 768);
            else if (np < 1216) { const int c = np - 1152, n = (c >> 2) & 1, e = c & 3, fq = (c >> 3) & 3, wc = c >> 5; col = 1152 + 16 * wc + 4 * fq + e + 32 * n; }
            else { col = 0; valid = false; }
        }
        if (MAP == 4) {
            if (np < 1024) col = (np >> 7) * 192 + (np & 127);
            else { const int r = np - 1024, head = r >> 6, n = (r >> 2) & 1, e = r & 3, fq = (r >> 3) & 3, wcl = (r >> 5) & 1; col = head * 192 + 128 + 16 * wcl + 4 * fq + e + 32 * n; }
        }
        if (MAP == 5) { const int g = np >> 7; valid = ((k0 >> 7) == g); sp = src + g * 16384; sld = 128; kbase = k0 & 127; col = np & 127; cs = aux[np]; }
        static_assert(MAP != 5, "the block-diagonal map (per-column scale) is not handled by the vectorised loader");
        f32x4 cv[8];
#pragma unroll
        for (int i = 0; i < 8; ++i) { const int kk = kq + 8 * i;
            cv[i] = valid ? __builtin_nontemporal_load((const f32x4*)(sp + (size_t)(kbase + kk) * sld + col)) : (f32x4){0.f, 0.f, 0.f, 0.f}; }
#pragma unroll
        for (int i = 0; i < 8; ++i) { const int kk = kq + 8 * i;
            f32x4 v = cv[i];
            if (rscale) v = v * rscale[k0 + kk];
#pragma unroll
            for (int e = 0; e < 4; ++e) scr[kk * 33 + 4 * n4 + e] = v[e] * cs; }
        LDS_WAIT(); asm volatile("" ::: "memory");
        const int c = lane & 7;
#pragma unroll
        for (int j = 0; j < 4; ++j) { const int n = (lane >> 3) + 8 * j; const LAS float* s = scr + (8 * c) * 33 + n;
            u32x4 o; o.x = pk2(s[0 * 33], s[1 * 33]); o.y = pk2(s[2 * 33], s[3 * 33]); o.z = pk2(s[4 * 33], s[5 * 33]); o.w = pk2(s[6 * 33], s[7 * 33]);
            *(u32x4*)(dst + (size_t)(n0 + n) * K + k0 + 8 * c) = o; }
        LDS_WAIT(); asm volatile("" ::: "memory");
    }
}


#define XB_TMO      128
#define XB_XCNT(j)  (256  + 64 * (j))
#define XB_XSUB(j)  (1280 + 64 * (j))
#define XB_XGEN(j)  (2304 + 64 * (j))
#define XB_TOP      3328
#define XB_TOPGEN   3392
#define XCD_BAR_WORDS 3456
#define XB_SPIN_CAP (1u << 22)
__device__ __forceinline__ unsigned xb_ld(unsigned* p)              { return __hip_atomic_load(p, __ATOMIC_RELAXED, __HIP_MEMORY_SCOPE_AGENT); }
__device__ __forceinline__ unsigned xb_add(unsigned* p, unsigned v) { return __hip_atomic_fetch_add(p, v, __ATOMIC_RELAXED, __HIP_MEMORY_SCOPE_AGENT); }
__device__ __forceinline__ unsigned xb_xcc_id() { return (unsigned)__builtin_amdgcn_s_getreg((3 << 11) | 20) & 0xFu; }
#define XB_SPIN(cond, bar) do { unsigned _sp = 0; while (cond) { __builtin_amdgcn_s_sleep(1); \
    if ((++_sp & 255u) == 0u) { if (xb_ld(&(bar)[XB_TMO])) break; if (_sp > XB_SPIN_CAP) { atomicAdd(&(bar)[XB_TMO], 1u); break; } } } } while (0)
__device__ __forceinline__ void xcd_barrier_complete(unsigned* bar, unsigned x, unsigned& nloc, unsigned& nx) {
    const unsigned G = gridDim.x * gridDim.y * gridDim.z;
    unsigned sum, cnt, mine, sp = 0u;
    for (;;) {
        sum = 0u; cnt = 0u; mine = 0u;
#pragma unroll
        for (unsigned j = 0; j < 16; ++j) { const unsigned c = xb_ld(&bar[XB_XCNT(j)]); sum += c; cnt += (c > 0u) ? 1u : 0u; mine = (j == x) ? c : mine; }
        if (sum == G) break;
        __builtin_amdgcn_s_sleep(1);
        if ((++sp & 255u) == 0u) { if (xb_ld(&bar[XB_TMO])) break; if (sp > XB_SPIN_CAP) { atomicAdd(&bar[XB_TMO], 1u); break; } }
    }
    nloc = mine > 0u ? mine : 1u; nx = cnt > 0u ? cnt : 1u;
}
__device__ __forceinline__ void xcd_barrier(unsigned* bar, volatile LAS unsigned* st, int wave_s) {
    asm volatile("s_waitcnt vmcnt(0)" ::: "memory");
    __syncthreads();
    if (wave_s == 0 && fresh_lane() == 0) {
        const unsigned x = xb_xcc_id();
        __builtin_amdgcn_s_waitcnt(0);
        unsigned nloc = st[0], nx = st[1];
        if (nloc == 0u) { xcd_barrier_complete(bar, x, nloc, nx); st[0] = nloc; st[1] = nx; }
        const unsigned old = xb_add(&bar[XB_XSUB(x)], 1u);
        const unsigned gen = old / nloc;
        if (old + 1u == (gen + 1u) * nloc) {
            __builtin_amdgcn_fence(__ATOMIC_RELEASE, "agent");
            asm volatile("s_waitcnt vmcnt(0)" ::: "memory");
            const unsigned og = xb_add(&bar[XB_TOP], 1u);
            const unsigned tg = og / nx;
            if (og + 1u == (tg + 1u) * nx) xb_add(&bar[XB_TOPGEN], 1u);
            else XB_SPIN(xb_ld(&bar[XB_TOPGEN]) == tg, bar);
            __builtin_amdgcn_fence(__ATOMIC_ACQUIRE, "agent");
            xb_add(&bar[XB_XGEN(x)], 1u);
            asm volatile("s_waitcnt vmcnt(0)" ::: "memory");
        } else {
            XB_SPIN(xb_ld(&bar[XB_XGEN(x)]) == gen, bar);
            __builtin_amdgcn_fence(__ATOMIC_ACQUIRE, "agent");
            asm volatile("s_waitcnt vmcnt(0)" ::: "memory");
        }
    }
    __syncthreads();
}

typedef const __attribute__((address_space(4))) unsigned long long* kargp_t;
__device__ __forceinline__ unsigned long long karg(int idx) { kargp_t kp = (kargp_t)__builtin_amdgcn_kernarg_segment_ptr(); asm volatile("" : "+s"(kp)); return kp[idx]; }
#define GAS __attribute__((address_space(1)))
#define KF(idx) ((const float*)(const GAS float*)karg(idx))
enum { A_X = 0, A_POS, A_NORM_FFN1, A_FFN1_UP, A_FFN1_DOWN, A_NORM_MIX, A_W_IN, A_B_GATE, A_POOL_MAPS, A_POOL_SCALE, A_W_POOL_PROJ, A_Q_NORM, A_W_UQ, A_KV_NORM, A_W_UKV,
       A_W_ATTN_PROJ, A_W_OUT, A_NORM_FFN2, A_FFN2_UP, A_FFN2_DOWN, A_FINAL_NORM, A_OUT, A_WS, A_PH };


__device__ __forceinline__ void comb_pool_mat(const float* maps, const float* scale, const float* wpp, bf16_t* dst, LAS float* scr, int gw, int NGW, int lane, int& rot) {
    const int nitems = 4 * 16 * 16;
    int it0 = gw - rot; if (it0 < 0) it0 += NGW;
    rot = (rot + nitems) % NGW;
    LAS f32x4* scr4 = (LAS f32x4*)scr;
    for (int it = it0; it < nitems; it += NGW) {
        const int g = it >> 8, cb = (it >> 4) & 15, nb = it & 15, c0 = cb * 8, n = nb * 64 + lane;
        { const f32x4* m4 = (const f32x4*)(maps + (size_t)g * 16384 + (size_t)c0 * 128);
#pragma unroll
          for (int i = 0; i < 4; ++i) scr4[lane + 64 * i] = m4[lane + 64 * i]; }
        LDS_WAIT(); asm volatile("" ::: "memory");
        float a[8];
#pragma unroll
        for (int j = 0; j < 8; ++j) a[j] = 0.f;
        const float* wcol = wpp + (size_t)(g * 128) * 1024 + n;
        const f32x4* s4p = (const f32x4*)(scale + g * 128);
#pragma unroll 2
        for (int d4 = 0; d4 < 32; ++d4) {
            const f32x4 s4 = s4p[d4];
            const float w0 = wcol[(size_t)(4 * d4) * 1024] * s4[0], w1 = wcol[(size_t)(4 * d4 + 1) * 1024] * s4[1], w2 = wcol[(size_t)(4 * d4 + 2) * 1024] * s4[2], w3 = wcol[(size_t)(4 * d4 + 3) * 1024] * s4[3];
#pragma unroll
            for (int j = 0; j < 8; ++j) { const f32x4 m = scr4[j * 32 + d4]; a[j] += (m[0] * w0 + m[1] * w1) + (m[2] * w2 + m[3] * w3); }
        }
        u32x4 o; o.x = pk2(a[0], a[1]); o.y = pk2(a[2], a[3]); o.z = pk2(a[4], a[5]); o.w = pk2(a[6], a[7]);
        *(u32x4*)(dst + (size_t)n * 512 + g * 128 + c0) = o;
        LDS_WAIT(); asm volatile("" ::: "memory");
    }
}

__device__ __forceinline__ void conv_layer(int l, bf16_t* Wd, LAS float* scr, int gw, int NGW, int lane) {
    int rot = 0;
    const float* up1 = KF(A_FFN1_UP) + (size_t)l * 1024 * 5632; const float* dn1 = KF(A_FFN1_DOWN) + (size_t)l * 2816 * 1024;
    const float* up2 = KF(A_FFN2_UP) + (size_t)l * 1024 * 5632; const float* dn2 = KF(A_FFN2_DOWN) + (size_t)l * 2816 * 1024;
    const float* win = KF(A_W_IN) + (size_t)l * 1024 * INDIM;
    conv_mat<1>(up1, 5632, 1024, 5632, 0, Wd + W_UP1, KF(A_NORM_FFN1) + l * 1024, nullptr, scr, gw, NGW, lane, rot);
    conv_mat<0>(dn1, 1024, 2816, 1024, 0, Wd + W_DN1, nullptr, nullptr, scr, gw, NGW, lane, rot);
    conv_mat<2>(win, INDIM, 1024, 1280, 0, Wd + W_IN5, KF(A_NORM_MIX) + l * 1024, nullptr, scr, gw, NGW, lane, rot);
    conv_mat<0>(win, INDIM, 1024, 2048, 1216, Wd + W_G, KF(A_NORM_MIX) + l * 1024, nullptr, scr, gw, NGW, lane, rot);
    comb_pool_mat(KF(A_POOL_MAPS) + (size_t)l * 4 * 128 * 128, KF(A_POOL_SCALE) + l * 512, KF(A_W_POOL_PROJ) + (size_t)l * 512 * 1024, Wd + W_PP, scr, gw, NGW, lane, rot);
    conv_mat<4>(KF(A_W_UQ) + (size_t)l * 384 * 1536, 1536, 384, 1536, 0, Wd + W_UQ, KF(A_Q_NORM) + l * 384, nullptr, scr, gw, NGW, lane, rot);
    conv_mat<0>(KF(A_W_UKV) + (size_t)l * 256 * 2048, 2048, 256, 2048, 0, Wd + W_UKV, KF(A_KV_NORM) + l * 256, nullptr, scr, gw, NGW, lane, rot);
    conv_mat<0>(KF(A_W_ATTN_PROJ) + (size_t)l * 1024 * 1024, 1024, 1024, 1024, 0, Wd + W_AP, nullptr, nullptr, scr, gw, NGW, lane, rot);
    conv_mat<0>(KF(A_W_OUT) + (size_t)l * 1024 * 1024, 1024, 1024, 1024, 0, Wd + W_WO, nullptr, nullptr, scr, gw, NGW, lane, rot);
    conv_mat<1>(up2, 5632, 1024, 5632, 0, Wd + W_UP2, KF(A_NORM_FFN2) + l * 1024, nullptr, scr, gw, NGW, lane, rot);
    conv_mat<0>(dn2, 1024, 2816, 1024, 0, Wd + W_DN2, nullptr, nullptr, scr, gw, NGW, lane, rot);
}

__global__ void __launch_bounds__(512, 2) mk_fwd(Params p_unused) {
    extern __shared__ __attribute__((aligned(16))) unsigned char lds_raw[];
    cg::grid_group grid = cg::this_grid();
    LAS unsigned char* lds = (LAS unsigned char*)lds_raw;
#define PHASE_IDS \
    const int tid = fresh_tid(wave_s); int bx = blockIdx.x; asm volatile("" : "+s"(bx)); int G = gridDim.x; asm volatile("" : "+s"(G)); \
    const int lane = tid & 63, wave = __builtin_amdgcn_readfirstlane(tid >> 6); \
    const int vcu = (G % 8 == 0) ? (bx % 8) * (G / 8) + bx / 8 : bx;         \
    const int gw = vcu * 8 + wave, NGW = G * 8; (void)lane; (void)gw; (void)NGW;
#define WS_PTRS \
    unsigned char* ws = (unsigned char*)(GAS unsigned char*)karg(A_WS); \
    bf16_t* Wl = (l & 1) ? (bf16_t*)(GAS bf16_t*)karg(A_OUT) : (bf16_t*)(ws + WS_W); bf16_t* XB = (bf16_t*)(ws + WS_XB); \
    float* SSQX = (float*)(ws + WS_SSQX); float* SSQQ = (float*)(ws + WS_SSQQ); float* SSQKV = (float*)(ws + WS_SSQKV); float* CS = (float*)(ws + WS_CS); \
    unsigned char* big = ws + WS_BIG; \
    bf16_t* H = (bf16_t*)(big + B_H * MiB); \
    bf16_t* QB = (bf16_t*)(big + B_QB * MiB); bf16_t* KN = (bf16_t*)(big + B_KN * MiB); bf16_t* VT = (bf16_t*)(big + B_VT * MiB); bf16_t* KR = (bf16_t*)(big + B_KR * MiB); \
    bf16_t* POOLED = (bf16_t*)(big + B_POOLED * MiB); bf16_t* AO = (bf16_t*)(big + B_AO * MiB); bf16_t* MIXED = (bf16_t*)(big + B_MIXED * MiB); \
    bf16_t* XPOOL = (bf16_t*)(big + B_XPOOL * MiB); bf16_t* KVLAT = (bf16_t*)(big + B_KVLAT * MiB); bf16_t* QLAT = (bf16_t*)(big + B_QLAT * MiB); \
    bf16_t* GT = (bf16_t*)(big + B_G * MiB); bf16_t* MB = (bf16_t*)(big + B_MB * MiB); \
    float* X = (float*)(GAS float*)karg(A_OUT); \
    (void)Wl; (void)XB; (void)SSQX; (void)SSQQ; (void)SSQKV; (void)CS; (void)H; (void)QB; (void)KN; (void)VT; (void)KR; (void)POOLED; (void)AO; (void)MIXED; (void)XPOOL; (void)KVLAT; (void)QLAT; (void)GT; (void)MB; (void)X;
    const unsigned long long phw = karg(A_PH); const int ph_lo = (int)(unsigned)phw, ph_hi = (int)(unsigned)(phw >> 32);
    volatile LAS unsigned* bst = (volatile LAS unsigned*)(lds + 131072 + 64);
    const int wave_s = __builtin_amdgcn_readfirstlane((int)threadIdx.x >> 6);
    if (wave_s == 0) ((LAS unsigned*)(lds + 131072))[fresh_lane()] = 0u;
    __syncthreads();
    if (wave_s == 0 && fresh_lane() == 0) { unsigned* bar0 = (unsigned*)(GAS unsigned*)karg(A_WS); (void)xb_add(&bar0[XB_XCNT(xb_xcc_id())], 1u); }
    for (int ph = ph_lo; ph < ph_hi; ++ph) {
        if (ph > 0 && ph < NPH - 1 && (ph % NPH_LAYER) == 0) continue;
        if (ph > ph_lo) { if (ph == ph_lo + 1) grid.sync(); else xcd_barrier((unsigned*)(GAS unsigned*)karg(A_WS), bst, wave_s); }
        const int l = ph / NPH_LAYER, k = (ph == NPH - 1) ? 10 : ph % NPH_LAYER;
#ifdef PROBE_DOUBLE
        const int nrep = ((PROBE_DOUBLE >> k) & 1) ? 2 : 1;
        for (int rep = 0; rep < nrep; ++rep) { if (rep) xcd_barrier((unsigned*)(GAS unsigned*)karg(A_WS), bst, wave_s);
        const float rscale = rep ? 0.f : 1.f;
#else
        const float rscale = 1.f;
        {
#endif
        if (k == 0) { PHASE_IDS WS_PTRS
            LAS float* scr = (LAS float*)(lds + wave * 16384);
            conv_layer(0, Wl, scr, gw, NGW, lane);
            if (l == 0) {
                for (int m = gw; m < M; m += NGW) {
                    const f32x4* xr = (const f32x4*)(KF(A_X) + (size_t)m * DM) + lane; f32x4 v[4]; float s = 0.f;
#pragma unroll
                    for (int j = 0; j < 4; ++j) { v[j] = __builtin_nontemporal_load(xr + 64 * j); s += dot4(v[j]); }
                    s = wave_sum(s);
                    u32x2* xb = (u32x2*)(XB + (size_t)m * DM) + lane;
#pragma unroll
                    for (int j = 0; j < 4; ++j) { u32x2 w; w.x = pk2(v[j][0], v[j][1]); w.y = pk2(v[j][2], v[j][3]); xb[64 * j] = w; }
                    if (lane < 16) SSQX[(size_t)m * 16 + lane] = (lane == 0) ? s : 0.f;
                    if (lane < 32) { const float ang = (float)((const int*)(const GAS int*)karg(A_POS))[m] * INVF[lane];
                        const double rev = (double)ang * 0.15915494309189533577; const float fr = (float)(rev - __builtin_rint(rev));
                        f32x2_t cs2 = {__builtin_amdgcn_cosf(fr), __builtin_amdgcn_sinf(fr)};
                        *(f32x2_t*)(CS + ((size_t)m * 32 + lane) * 2) = cs2; }
                }
            }
            __syncthreads();
        } else if (k == 1 || k == 8) { PHASE_IDS WS_PTRS
            pg8::Gemm g{XB, Wl + (k == 1 ? W_UP1 : W_UP2), M, 5632, 1024}; pg8::StaticOrder S; S.init(M, 5632, G, bx);
            EpiSwiglu E{H, SSQX};
            pg8::gemm_phase<EpiSwiglu>(lds, g, S, E, wave_s);
        } else if (k == 2 || k == 9) { PHASE_IDS WS_PTRS
            pg8::Gemm g{H, Wl + (k == 2 ? W_DN1 : W_DN2), M, 1024, 2816}; pg8::StaticOrder S; S.init(M, 1024, G, bx);
            EpiResid E{XB, SSQX, 0.5f * rscale};
            pg8::gemm_phase<EpiResid>(lds, g, S, E, wave_s);
        } else if (k == 3) { PHASE_IDS WS_PTRS
            pg8::Gemm g{XB, Wl + W_IN5, M, 1280, 1024}; pg8::StaticOrder S; S.init(M, 1280, G, bx);
            EpiIn E{SSQX, XPOOL, KVLAT, QLAT, KR, SSQQ, SSQKV, CS};
            pg8::gemm_phase<EpiIn>(lds, g, S, E, wave_s);
            if (l + 1 < DEPTH) {
                const int rem = S.nwg % G, nidle = rem ? G - rem : G, me = rem ? bx - rem : bx;
                if (me >= 0) { bf16_t* Wn = ((l + 1) & 1) ? (bf16_t*)(GAS bf16_t*)karg(A_OUT) : (bf16_t*)(ws + WS_W);
                    conv_layer(l + 1, Wn, (LAS float*)(lds + wave * 16384), me * 8 + wave, nidle * 8, lane); }
                __syncthreads();
            }
        } else if (k == 4) { PHASE_IDS WS_PTRS
            { const int nthr = G * 512, gt = vcu * 512 + tid;
              for (int idx = gt; idx < M * 64; idx += nthr) {
                  const int row = idx >> 6, ch = idx & 63, s = row & (SEQ - 1), w = 2 << (ch >> 4), cnt = (s + 1 < w) ? s + 1 : w;
                  const bf16_t* xp = XPOOL + (size_t)row * 512 + ch * 8;
                  float a[8];
#pragma unroll
                  for (int e = 0; e < 8; ++e) a[e] = 0.f;
                  u32x4 wv[16];
#pragma unroll
                  for (int j = 0; j < 16; ++j) wv[j] = (j < cnt) ? *(const u32x4*)(xp - (size_t)j * 512) : (u32x4){0u, 0u, 0u, 0u};
                  const u32x4 self = wv[0];
#pragma unroll
                  for (int j = 0; j < 16; ++j) { const u32x4 v = wv[j];
                      a[0] += bf2f(v.x & 0xffffu); a[1] += bf2f(v.x >> 16); a[2] += bf2f(v.y & 0xffffu); a[3] += bf2f(v.y >> 16);
                      a[4] += bf2f(v.z & 0xffffu); a[5] += bf2f(v.z >> 16); a[6] += bf2f(v.w & 0xffffu); a[7] += bf2f(v.w >> 16); }
                  const float ic = 1.0f / (float)cnt;
                  u32x4 o;
                  o.x = pk2(a[0] * ic - bf2f(self.x & 0xffffu), a[1] * ic - bf2f(self.x >> 16)); o.y = pk2(a[2] * ic - bf2f(self.y & 0xffffu), a[3] * ic - bf2f(self.y >> 16));
                  o.z = pk2(a[4] * ic - bf2f(self.z & 0xffffu), a[5] * ic - bf2f(self.z >> 16)); o.w = pk2(a[6] * ic - bf2f(self.w & 0xffffu), a[7] * ic - bf2f(self.w >> 16));
                  *(u32x4*)(POOLED + (size_t)row * 512 + ch * 8) = o;
              } }
            { pg8::Gemm g{QLAT, Wl + W_UQ, M, 1536, QLR}; pg8::StaticOrder S; S.init(M, 1536, G, bx);
              EpiQ E{SSQQ, CS, QB};
              pg8::gemm_phase<EpiQ>(lds, g, S, E, wave_s); }
            { pg8::Gemm g{KVLAT, Wl + W_UKV, M, 2048, KVLR}; pg8::StaticOrder S; S.init(M, 2048, G, bx);
              EpiKV E{SSQKV, KN, VT, lds + LDS_EXTRA};
              pg8::gemm_phase<EpiKV>(lds, g, S, E, wave_s); }
        } else if (k == 5) { PHASE_IDS WS_PTRS
            for (int kk = vcu; kk < 256; kk += G)
                for (int i = 0; i < 2; ++i) { const int id = 2 * kk + i, bh = id >> 2, s = id & 3;
                    att::attn_unit(lds, bh >> 3, bh & 7, s, QB, KN, KR, VT, AO, wave_s);
                    att::attn_unit(lds, bh >> 3, bh & 7, 7 - s, QB, KN, KR, VT, AO, wave_s); }
        } else if (k == 6) { PHASE_IDS WS_PTRS
            const float* bg = KF(A_B_GATE) + (size_t)l * 2048;
            ProgMerge P;
            P.S.init(M, 1024, G, bx); P.n = (P.S.nwg > bx) ? (P.S.nwg - bx + G - 1) / G : 0;
            P.XB = XB; P.MIXED = POOLED; P.AO = AO; P.Wg = Wl + W_G; P.Wpp = Wl + W_PP; P.Wap = Wl + W_AP;
            P.EA = EpiGate{SSQX, bg, GT}; P.EB = EpiGate{SSQX, bg + 1024, GT}; P.E0 = EpiGated<0>{GT, MB}; P.E1 = EpiGated<1>{GT, MB};
            pg8::gemm_stream<ProgMerge>(lds, P, wave_s);
        } else if (k == 7) { PHASE_IDS WS_PTRS
            pg8::Gemm g{MB, Wl + W_WO, M, 1024, 1024}; pg8::StaticOrder S; S.init(M, 1024, G, bx);
            EpiResid E{XB, SSQX, 1.0f * rscale};
            pg8::gemm_phase<EpiResid>(lds, g, S, E, wave_s);
        } else { PHASE_IDS WS_PTRS
            for (int m = gw; m < M; m += NGW) {
                f32x4* xr = (f32x4*)(X + (size_t)m * DM) + lane; const u32x2* xb = (const u32x2*)(XB + (size_t)m * DM) + lane; const f32x4* gr = (const f32x4*)KF(A_FINAL_NORM) + lane; f32x4 v[4]; float s = 0.f;
#pragma unroll
                for (int j = 0; j < 4; ++j) { const u32x2 w = xb[64 * j]; v[j] = (f32x4){bf2f(w.x & 0xffffu), bf2f(w.x >> 16), bf2f(w.y & 0xffffu), bf2f(w.y >> 16)}; s += dot4(v[j]); }
                const float rstd = __builtin_amdgcn_rsqf(wave_sum(s) * (1.0f / 1024.0f) + EPS);
#pragma unroll
                for (int j = 0; j < 4; ++j) __builtin_nontemporal_store(v[j] * rstd * gr[64 * j], xr + 64 * j);
            }
        }
        }
    }
}

#ifndef MK_ONE_LAUNCH
#define MK_ONE_LAUNCH 1
#endif
extern "C" void kernel_launch(void* const* d_in, const int* in_sizes, int n_in, void* d_out, int out_size, void* d_ws, size_t ws_size, hipStream_t stream) {
    static int grid = 0;
    if (grid == 0) {
        if (n_in != 21 || in_sizes[0] != M * DM || out_size != M * DM || ws_size < WS_END) {
            fprintf(stderr, "kernel_launch: unexpected shapes (n_in %d, in0 %d, out %d, ws %zu need %zu); nothing launched\n", n_in, n_in > 0 ? in_sizes[0] : -1, out_size, ws_size, (size_t)WS_END);
            grid = -1; return; }
        int dev = 0, cus = 0, per_cu = 0;
        if (hipGetDevice(&dev) != hipSuccess || hipDeviceGetAttribute(&cus, hipDeviceAttributeMultiprocessorCount, dev) != hipSuccess) { grid = -1; return; }
        if (hipFuncSetAttribute((const void*)mk_fwd, hipFuncAttributeMaxDynamicSharedMemorySize, LDS_BYTES) != hipSuccess) { fprintf(stderr, "kernel_launch: hipFuncSetAttribute failed\n"); grid = -1; return; }
        if (hipOccupancyMaxActiveBlocksPerMultiprocessor(&per_cu, (const void*)mk_fwd, 512, LDS_BYTES) != hipSuccess || per_cu < 1) { fprintf(stderr, "kernel_launch: occupancy query says %d\n", per_cu); per_cu = 1; }
        (void)hipGetLastError();
        grid = cus * per_cu;
    }
    if (grid < 0) return;
    if (hipMemsetAsync(d_ws, 0, 16384, stream) != hipSuccess) { fprintf(stderr, "kernel_launch: memset of the barrier words failed\n"); return; }
    Params p{};
    p.x = (const float*)d_in[0]; p.pos = (const int*)d_in[1]; p.norm_ffn1 = (const float*)d_in[2]; p.ffn1_up = (const float*)d_in[3]; p.ffn1_down = (const float*)d_in[4];
    p.norm_mix = (const float*)d_in[5]; p.w_in = (const float*)d_in[6]; p.b_gate = (const float*)d_in[7]; p.pool_maps = (const float*)d_in[8]; p.pool_scale = (const float*)d_in[9];
    p.w_pool_proj = (const float*)d_in[10]; p.q_latent_norm = (const float*)d_in[11]; p.w_uq = (const float*)d_in[12]; p.kv_latent_norm = (const float*)d_in[13]; p.w_ukv = (const float*)d_in[14];
    p.w_attn_proj = (const float*)d_in[15]; p.w_out = (const float*)d_in[16]; p.norm_ffn2 = (const float*)d_in[17]; p.ffn2_up = (const float*)d_in[18]; p.ffn2_down = (const float*)d_in[19];
    p.final_norm = (const float*)d_in[20];
    p.out = (float*)d_out; p.ws = (unsigned char*)d_ws;
#if MK_ONE_LAUNCH
    p.ph_lo = 0; p.ph_hi = NPH;
    void* args[] = {&p};
    hipError_t e = hipLaunchCooperativeKernel((const void*)mk_fwd, dim3(grid), dim3(512), args, LDS_BYTES, stream);
    if (e != hipSuccess) fprintf(stderr, "kernel_launch: cooperative launch failed: %s (grid %d)\n", hipGetErrorString(e), grid);
#else
    for (int ph = 0; ph < NPH; ++ph) { p.ph_lo = ph; p.ph_hi = ph + 1; hipLaunchKernelGGL(mk_fwd, dim3(grid), dim3(512), LDS_BYTES, stream, p); }
#endif
}
```
